# Optimizing an MI355X kernel written in HIP

```python
import jax
import jax.numpy as jnp
from jax import lax
import numpy as np

D_MODEL = 2048
BATCH = 4
SEQ = 4096
DEPTH = 2

GRID_W = 64
CTX_LEN = 256
HEAD_DIM = 128
MIX_DIM = D_MODEL
RET_HEADS = MIX_DIM // 2 // HEAD_DIM
RET_DIM = RET_HEADS * HEAD_DIM
RET_CHUNK = 128
GMLP_DIM = MIX_DIM - RET_DIM
GMLP_GROUPS = 8
GMLP_CHUNK = 128
NA_HEADS = MIX_DIM // 2 // HEAD_DIM
NA_DIM = NA_HEADS * HEAD_DIM
WIN_ROWS = 8
WIN_COLS = 16
GLA_HEADS = 8
GLA_DV = (MIX_DIM - NA_DIM) // GLA_HEADS
GLA_DK = GLA_DV // 2
GLA_QK_DIM = GLA_HEADS * GLA_DK
GLA_V_DIM = GLA_HEADS * GLA_DV
GLA_GATE_RANK = 16
GLA_TAU = 16.0
GLA_CHUNK = 64
N_EXPERTS = 16
D_EXPERT = 2048
EC_CAPACITY = 2
ROPE_BASE = 10000.0
RMS_EPS = 1e-6
N_EVEN = (DEPTH + 1) // 2
N_ODD = DEPTH // 2

EVEN_WIDTHS = (RET_DIM, RET_DIM, GMLP_DIM, GMLP_DIM, RET_DIM, RET_DIM)
EVEN_Q_COLS = 2 * RET_DIM + 2 * GMLP_DIM
EVEN_COLS = EVEN_Q_COLS + 2 * RET_DIM
ODD_Q_WIDTHS = (NA_DIM, GLA_QK_DIM, GLA_V_DIM)
ODD_KV_WIDTHS = (NA_DIM, NA_DIM, GLA_QK_DIM, GLA_V_DIM, 2 * GLA_GATE_RANK)
ODD_Q_COLS = NA_DIM + GLA_QK_DIM + GLA_V_DIM
ODD_COLS = ODD_Q_COLS + 2 * NA_DIM + GLA_QK_DIM + GLA_V_DIM + 2 * GLA_GATE_RANK

kernel_name = 'hybrid_diffusion_retention_gmlp_natten_gla_ecmoe'


def rmsnorm(x, gain):
    xf = x.astype(jnp.float32)
    xf = xf * lax.rsqrt(jnp.mean(xf * xf, axis=-1, keepdims=True) + RMS_EPS)
    return (xf * gain.astype(jnp.float32)).astype(x.dtype)


def split_cols(p, widths):
    return jnp.split(p, np.cumsum(widths)[:-1].tolist(), axis=-1)


def to_heads(z, n_heads):
    b, t, _ = z.shape
    return z.reshape(b, t, n_heads, -1).transpose(0, 2, 1, 3)


def merge_heads(z):
    b, h, t, d = z.shape
    return z.transpose(0, 2, 1, 3).reshape(b, t, h * d)


def head_rmsnorm(o, gain, dtype):
    of = o.astype(jnp.float32)
    of = of * lax.rsqrt(jnp.mean(of * of, axis=-1, keepdims=True) + RMS_EPS)
    return (merge_heads(of) * gain.astype(jnp.float32)).astype(dtype)


def axial_rotary(z, rows, cols):
    half = z.shape[-1] // 2
    nf = half // 2
    freq = ROPE_BASE ** (-jnp.arange(nf, dtype=jnp.float32) / nf)

    def rotate(u, pos):
        ang = pos.astype(jnp.float32)[:, None] * freq
        cos, sin = jnp.cos(ang).astype(u.dtype), jnp.sin(ang).astype(u.dtype)
        u1, u2 = u[..., :nf], u[..., nf:]
        return jnp.concatenate([u1 * cos - u2 * sin, u1 * sin + u2 * cos], axis=-1)

    return jnp.concatenate([rotate(z[..., :half], rows), rotate(z[..., half:], cols)], axis=-1)


def chunked_decay_attention(q, k, v, log_a, s0, chunk):
    B, H, T, dk = q.shape
    dv = v.shape[-1]
    n = T // chunk
    f32 = jnp.float32

    def blocks(z):
        return z.astype(f32).reshape(B, H, n, chunk, z.shape[-1])

    qc, kc, vc = blocks(q), blocks(k), blocks(v)
    b = jnp.cumsum(blocks(jnp.broadcast_to(log_a, q.shape)), axis=3)
    b_end = b[:, :, :, -1:, :]
    q_in = qc * jnp.exp(b)
    k_in = kc * jnp.exp(-b)
    k_out = kc * jnp.exp(b_end - b)
    tri = jnp.tril(jnp.ones((chunk, chunk), dtype=bool))
    att = jnp.where(tri, jnp.einsum('bhntd,bhnsd->bhnts', q_in, k_in), 0.0)
    o_intra = jnp.einsum('bhnts,bhnse->bhnte', att, vc)
    kv = jnp.einsum('bhnsd,bhnse->bhnde', k_out, vc)
    dec = jnp.exp(b_end[:, :, :, 0, :])

    def step(S, inp):
        kv_i, dec_i = inp
        return dec_i[..., None] * S + kv_i, S

    s_fin, s_in = lax.scan(step, s0.astype(f32), (jnp.moveaxis(kv, 2, 0), jnp.moveaxis(dec, 2, 0)))
    o_inter = jnp.einsum('bhntd,nbhde->bhnte', q_in, s_in)
    return (o_intra + o_inter).reshape(B, H, T, dv), s_fin


def decayed_final_state(k, v, log_a):
    la = jnp.broadcast_to(log_a, k.shape).astype(jnp.float32)
    cum = jnp.cumsum(la, axis=2)
    w = jnp.exp(cum[:, :, -1:, :] - cum)
    return jnp.einsum('bhtd,bhte->bhde', k.astype(jnp.float32) * w, v.astype(jnp.float32))


def bidir_decay_attention(q, k, v, la, q_c, k_c, v_c, la_c, chunk):
    B, H, _, dk = k.shape
    dv = v.shape[-1]
    s_zero = jnp.zeros((B, H, dk, dv), jnp.float32)
    o_lat = 0.0
    o_ctx = None if q_c is None else 0.0
    for d in range(2):
        fl = (lambda z: z) if d == 0 else (lambda z: jnp.flip(z, axis=2))
        if q_c is None:
            s_c = decayed_final_state(fl(k_c), fl(v_c), fl(la_c[d]))
        else:
            oc, s_c = chunked_decay_attention(fl(q_c), fl(k_c), fl(v_c), fl(la_c[d]), s_zero, chunk)
            o_ctx = o_ctx + fl(oc)
        ol, _ = chunked_decay_attention(fl(q), fl(k), fl(v), fl(la[d]), s_c, chunk)
        o_lat = o_lat + fl(ol)
    return o_ctx, o_lat


def chunk_gmlp(u, v, norm_gain, ws, bs):
    B, T, _ = u.shape
    u = jax.nn.gelu(u)
    v = rmsnorm(jax.nn.gelu(v), norm_gain)
    vc = v.reshape(B, T // GMLP_CHUNK, GMLP_CHUNK, GMLP_GROUPS, -1)
    mixed = jnp.einsum('gps,bnsgc->bnpgc', ws, vc) + bs.T[None, None, :, :, None]
    return u * mixed.reshape(B, T, -1).astype(u.dtype)


def context_attention(q, k, v):
    s = jnp.einsum('bhqd,bhkd->bhqk', q, k).astype(jnp.float32) * (q.shape[-1] ** -0.5)
    return jnp.einsum('bhqk,bhkd->bhqd', jax.nn.softmax(s, axis=-1).astype(v.dtype), v)


def neighbourhood_attention(q, k, v, k_ctx, v_ctx, rpb):
    B, H, T, dh = q.shape
    rows = T // GRID_W
    wr, wc = min(WIN_ROWS, rows), WIN_COLS
    grid = lambda z: z.reshape(B, H, rows, GRID_W, dh)
    qg, kg, vg = grid(q * (dh ** -0.5)), grid(k), grid(v)
    col = jnp.arange(GRID_W)
    cstart = jnp.clip(col - wc // 2, 0, GRID_W - wc)
    cidx = cstart[:, None] + jnp.arange(wc)[None, :]
    rpb_c = rpb[:, :, cidx - col[:, None] + (WIN_COLS - 1)]

    def row_block(args):
        r, q_r = args
        rstart = jnp.clip(r - wr // 2, 0, rows - wr)
        k_win = lax.dynamic_slice_in_dim(kg, rstart, wr, axis=2)[:, :, :, cidx, :]
        v_win = lax.dynamic_slice_in_dim(vg, rstart, wr, axis=2)[:, :, :, cidx, :]
        dr = rstart + jnp.arange(wr) - r + (WIN_ROWS - 1)
        bias = jnp.take(rpb_c, dr, axis=1).transpose(0, 2, 1, 3)
        s_win = jnp.einsum('bhqd,bhiqjd->bhqij', q_r, k_win).astype(jnp.float32) + bias[None].astype(jnp.float32)
        s_ctx = jnp.einsum('bhqd,bhld->bhql', q_r, k_ctx).astype(jnp.float32)
        s = jnp.concatenate([s_win.reshape(B, H, GRID_W, wr * wc), s_ctx], axis=-1)
        p = jax.nn.softmax(s, axis=-1).astype(v.dtype)
        p_win = p[..., :wr * wc].reshape(B, H, GRID_W, wr, wc)
        return (jnp.einsum('bhqij,bhiqjd->bhqd', p_win, v_win)
                + jnp.einsum('bhql,bhld->bhqd', p[..., wr * wc:], v_ctx))

    out = lax.map(row_block, (jnp.arange(rows), jnp.moveaxis(qg, 2, 0)))
    return jnp.moveaxis(out, 0, 2).reshape(B, H, T, dh)


def gla_log_decay(lr, w_up, b_up, d):
    z = lr[..., d * GLA_GATE_RANK:(d + 1) * GLA_GATE_RANK] @ w_up[d] + b_up[d]
    return to_heads(jax.nn.log_sigmoid(z.astype(jnp.float32)) / GLA_TAU, GLA_HEADS)


def even_mixer(h, hc, w_in, w_out, gamma_logit, ret_norm, gmlp_norm, gmlp_ws, gmlp_bs, last):
    T = h.shape[1]
    t = jnp.arange(T)
    rows, cols = t // GRID_W, t % GRID_W
    scale = HEAD_DIM ** -0.5
    rq, rg, u, vg, rk, rv = split_cols(h @ w_in, EVEN_WIDTHS)
    log_g = jax.nn.log_sigmoid(gamma_logit.astype(jnp.float32))
    la = [log_g[d][None, :, None, None] for d in range(2)]
    q_l = axial_rotary(to_heads(rq, RET_HEADS) * scale, rows, cols)
    k_l = axial_rotary(to_heads(rk, RET_HEADS), rows, cols)
    v_l = to_heads(rv, RET_HEADS)
    if last:
        ck, cv = split_cols(hc @ w_in[:, EVEN_Q_COLS:], EVEN_WIDTHS[4:])
        cq = None
    else:
        cq, cg, cu, cvg, ck, cv = split_cols(hc @ w_in, EVEN_WIDTHS)
        cq = to_heads(cq, RET_HEADS) * scale
    o_c, o_l = bidir_decay_attention(q_l, k_l, v_l, la, cq, to_heads(ck, RET_HEADS), to_heads(cv, RET_HEADS), la, RET_CHUNK)
    ret_lat = head_rmsnorm(o_l, ret_norm, h.dtype) * jax.nn.silu(rg)
    y = jnp.concatenate([ret_lat, chunk_gmlp(u, vg, gmlp_norm, gmlp_ws, gmlp_bs)], axis=-1) @ w_out
    if last:
        return None, y
    ret_ctx = head_rmsnorm(o_c, ret_norm, hc.dtype) * jax.nn.silu(cg)
    yc = jnp.concatenate([ret_ctx, chunk_gmlp(cu, cvg, gmlp_norm, gmlp_ws, gmlp_bs)], axis=-1) @ w_out
    return yc, y


def odd_mixer(h, hc, w_in, w_out, rpb, w_up, b_up, gla_norm, last):
    p = h @ w_in
    nq, gq, gr = split_cols(p[..., :ODD_Q_COLS], ODD_Q_WIDTHS)
    nk, nv, gk, gv, glr = split_cols(p[..., ODD_Q_COLS:], ODD_KV_WIDTHS)
    if last:
        pc_kv = hc @ w_in[:, ODD_Q_COLS:]
    else:
        pc = hc @ w_in
        cnq, cgq, cgr = split_cols(pc[..., :ODD_Q_COLS], ODD_Q_WIDTHS)
        pc_kv = pc[..., ODD_Q_COLS:]
    cnk, cnv, cgk, cgv, clr = split_cols(pc_kv, ODD_KV_WIDTHS)
    nk_c, nv_c = to_heads(cnk, NA_HEADS), to_heads(cnv, NA_HEADS)
    o_na = neighbourhood_attention(to_heads(nq, NA_HEADS), to_heads(nk, NA_HEADS), to_heads(nv, NA_HEADS), nk_c, nv_c, rpb)
    la_l = [gla_log_decay(glr, w_up, b_up, d) for d in range(2)]
    la_c = [gla_log_decay(clr, w_up, b_up, d) for d in range(2)]
    qscale = GLA_DK ** -0.5
    cq = None if last else to_heads(cgq, GLA_HEADS) * qscale
    o_c, o_l = bidir_decay_attention(to_heads(gq, GLA_HEADS) * qscale, to_heads(gk, GLA_HEADS), to_heads(gv, GLA_HEADS), la_l,
                                     cq, to_heads(cgk, GLA_HEADS), to_heads(cgv, GLA_HEADS), la_c, GLA_CHUNK)
    gla_lat = head_rmsnorm(o_l, gla_norm, h.dtype) * jax.nn.silu(gr)
    y = jnp.concatenate([merge_heads(o_na), gla_lat], axis=-1) @ w_out
    if last:
        return None, y
    o_na_c = context_attention(to_heads(cnq, NA_HEADS), nk_c, nv_c)
    gla_ctx = head_rmsnorm(o_c, gla_norm, hc.dtype) * jax.nn.silu(cgr)
    yc = jnp.concatenate([merge_heads(o_na_c), gla_ctx], axis=-1) @ w_out
    return yc, y


def expert_choice_ffn(h, router_w, w_gate, w_up, w_down):
    B, T, _ = h.shape
    cap = EC_CAPACITY * T // N_EXPERTS
    aff = jax.nn.softmax((h @ router_w).astype(jnp.float32), axis=-1)
    g, idx = lax.top_k(aff.transpose(0, 2, 1), cap)
    b_idx = jnp.arange(B)[:, None, None]
    xs = h[b_idx, idx]
    a = jnp.einsum('becd,edf->becf', xs, w_gate)
    up = jnp.einsum('becd,edf->becf', xs, w_up)
    y = jnp.einsum('becf,efd->becd', jax.nn.silu(a) * up, w_down) * g[..., None].astype(h.dtype)
    return jnp.zeros_like(h).at[b_idx, idx].add(y.astype(h.dtype))


def setup_inputs(seed: int = 0) -> dict:
    key = jax.random.key(seed)
    ks = iter(jax.random.split(key, 32))
    f32 = jnp.float32
    nrm = lambda shape, s: jax.random.normal(next(ks), shape, f32) * s
    D = D_MODEL
    base_logit = jnp.log(2.0 ** (5.0 + jnp.arange(RET_HEADS, dtype=f32)) - 1.0)
    return {
        'x': nrm((BATCH, SEQ, D), 1.0),
        'c': nrm((BATCH, D), 1.0),
        'ctx': nrm((BATCH, CTX_LEN, D), 1.0),
        'c_ctx': nrm((D,), 1.0),
        'ada_w': nrm((DEPTH, D, 6 * D), 0.5 * D ** -0.5),
        'ada_b': nrm((DEPTH, 6 * D), 0.01),
        'norm_mix': 1.0 + nrm((DEPTH, D), 0.05),
        'norm_ffn': 1.0 + nrm((DEPTH, D), 0.05),
        'norm_final': 1.0 + nrm((D,), 0.05),
        'ev_w_in': nrm((N_EVEN, D, EVEN_COLS), D ** -0.5),
        'ev_w_out': nrm((N_EVEN, MIX_DIM, D), MIX_DIM ** -0.5),
        'ret_gamma_logit': base_logit + nrm((N_EVEN, 2, RET_HEADS), 0.1),
        'ret_norm': 1.0 + nrm((N_EVEN, RET_DIM), 0.05),
        'gmlp_norm': 1.0 + nrm((N_EVEN, GMLP_DIM), 0.05),
        'gmlp_ws': nrm((N_EVEN, GMLP_GROUPS, GMLP_CHUNK, GMLP_CHUNK), GMLP_CHUNK ** -0.5),
        'gmlp_bs': 1.0 + nrm((N_EVEN, GMLP_GROUPS, GMLP_CHUNK), 0.1),
        'od_w_in': nrm((N_ODD, D, ODD_COLS), D ** -0.5),
        'od_w_out': nrm((N_ODD, MIX_DIM, D), MIX_DIM ** -0.5),
        'na_rpb': nrm((N_ODD, NA_HEADS, 2 * WIN_ROWS - 1, 2 * WIN_COLS - 1), 0.1),
        'gla_w_up': nrm((N_ODD, 2, GLA_GATE_RANK, GLA_QK_DIM), GLA_GATE_RANK ** -0.5),
        'gla_b_up': nrm((N_ODD, 2, GLA_QK_DIM), 0.1),
        'gla_norm': 1.0 + nrm((N_ODD, GLA_V_DIM), 0.05),
        'router_w': nrm((DEPTH, D, N_EXPERTS), D ** -0.5),
        'moe_w_gate': nrm((DEPTH, N_EXPERTS, D, D_EXPERT), D ** -0.5),
        'moe_w_up': nrm((DEPTH, N_EXPERTS, D, D_EXPERT), D ** -0.5),
        'moe_w_down': nrm((DEPTH, N_EXPERTS, D_EXPERT, D), D_EXPERT ** -0.5),
    }


def reference(x, c, ctx, c_ctx, ada_w, ada_b, norm_mix, norm_ffn, norm_final,
              ev_w_in, ev_w_out, ret_gamma_logit, ret_norm, gmlp_norm, gmlp_ws, gmlp_bs,
              od_w_in, od_w_out, na_rpb, gla_w_up, gla_b_up, gla_norm,
              router_w, moe_w_gate, moe_w_up, moe_w_down):
    for l in range(DEPTH):
        last = l == DEPTH - 1
        li = l // 2
        mod = jax.nn.silu(c) @ ada_w[l] + ada_b[l]
        sh1, sc1, g1, sh2, sc2, g2 = [m[:, None, :] for m in jnp.split(mod, 6, axis=-1)]
        n_ctx = 2 if last else 6
        mc = jnp.split(jax.nn.silu(c_ctx) @ ada_w[l][:, :n_ctx * D_MODEL] + ada_b[l][:n_ctx * D_MODEL], n_ctx)
        h = rmsnorm(x, norm_mix[l]) * (1.0 + sc1) + sh1
        hc = rmsnorm(ctx, norm_mix[l]) * (1.0 + mc[1]) + mc[0]
        if l % 2 == 0:
            yc, y = even_mixer(h, hc, ev_w_in[li], ev_w_out[li], ret_gamma_logit[li], ret_norm[li],
                               gmlp_norm[li], gmlp_ws[li], gmlp_bs[li], last)
        else:
            yc, y = odd_mixer(h, hc, od_w_in[li], od_w_out[li], na_rpb[li], gla_w_up[li], gla_b_up[li],
                              gla_norm[li], last)
        x = x + g1 * y
        h2 = rmsnorm(x, norm_ffn[l]) * (1.0 + sc2) + sh2
        x = x + g2 * expert_choice_ffn(h2, router_w[l], moe_w_gate[l], moe_w_up[l], moe_w_down[l])
        if not last:
            ctx = ctx + mc[2] * yc
            hc2 = rmsnorm(ctx, norm_ffn[l]) * (1.0 + mc[4]) + mc[3]
            ctx = ctx + mc[5] * expert_choice_ffn(hc2, router_w[l], moe_w_gate[l], moe_w_up[l], moe_w_down[l])
    return rmsnorm(x, norm_final)
```

```cpp
#include <hip/hip_runtime.h>
#include <cstdio>
#include <cstdint>

#ifndef MK_SPLIT
#define MK_SPLIT 0
#endif

#define LAS __attribute__((address_space(3)))
typedef unsigned short bf16_t;
typedef short bf16x8 __attribute__((ext_vector_type(8)));
typedef float f32x4 __attribute__((ext_vector_type(4)));
typedef float f32x2 __attribute__((ext_vector_type(2)));
typedef unsigned u32x4 __attribute__((ext_vector_type(4)));
typedef unsigned u32x2 __attribute__((ext_vector_type(2)));
typedef short s16x4 __attribute__((ext_vector_type(4)));

constexpr int D = 2048, NB = 4, T = 4096, CL = 256, NE = 16;
constexpr int M_LAT = NB * T, M_CTX = NB * CL, M_ALL = M_LAT + M_CTX;
constexpr float EPS = 1e-6f;
constexpr int LDP0 = 6144, LDP1 = 6400;
constexpr int RPE0 = 2304, RPE1 = 2048;
constexpr int NPH = 22;

constexpr size_t MiB = 1u << 20;
constexpr size_t WS_CTL = 0, CTL_BYTES = 1 * MiB;
constexpr size_t WS_MOD = 1 * MiB;
constexpr size_t WS_ROT = 2 * MiB;
constexpr size_t WS_GMW = 2 * MiB + 512 * 1024;
constexpr size_t WS_AFF = 3 * MiB;
constexpr size_t WS_SRC = 5 * MiB;
constexpr size_t WS_GATE = 6 * MiB;
constexpr size_t WS_INV = 7 * MiB;
constexpr size_t WS_WIN0 = 16 * MiB, WS_WOUT0 = 40 * MiB, WS_WIN1 = 48 * MiB, WS_WOUT1 = 74 * MiB;
constexpr size_t WS_WGU = 82 * MiB;
constexpr size_t WS_WDN = 594 * MiB;
constexpr size_t WS_X1 = 850 * MiB;
constexpr size_t WS_HB = 986 * MiB;
constexpr size_t WS_P = 1054 * MiB;
constexpr size_t WS_AO = 1267 * MiB;
constexpr size_t WS_OF = 1335 * MiB, WS_OB = 1403 * MiB;
constexpr size_t WS_XG = 1471 * MiB, WS_HM = 1615 * MiB, WS_YE = 1759 * MiB;
constexpr size_t WS_END = 1903 * MiB;

constexpr int LDS_BYTES = 147456;
constexpr int LDS_BARW = LDS_BYTES - 64;

__device__ __forceinline__ float bf2f(unsigned v) { return __uint_as_float(v << 16); }
__device__ __forceinline__ float bflo(unsigned w) { return __uint_as_float(w << 16); }
__device__ __forceinline__ float bfhi(unsigned w) { return __uint_as_float(w & 0xffff0000u); }
typedef __bf16 bf2_t __attribute__((ext_vector_type(2)));
__device__ __forceinline__ unsigned f2bf(float f) { return (unsigned)__builtin_bit_cast(unsigned short, (__bf16)f); }
__device__ __forceinline__ unsigned pk2(float lo, float hi) { bf2_t v; v[0] = (__bf16)lo; v[1] = (__bf16)hi; return __builtin_bit_cast(unsigned, v); }
__device__ __forceinline__ float silu_f(float x) { return x / (1.f + __expf(-x)); }
__device__ __forceinline__ float gelu_tanh_f(float x) { const float y = 0.7978845608028654f * (x + 0.044715f * x * x * x); return x / (1.f + __expf(-2.f * y)); }
__device__ __forceinline__ float wave_sum(float v) {
#pragma unroll
    for (int o = 1; o < 64; o <<= 1) v += __shfl_xor(v, o);
    return v;
}
__device__ __forceinline__ float wave_max(float v) {
#pragma unroll
    for (int o = 1; o < 64; o <<= 1) v = fmaxf(v, __shfl_xor(v, o));
    return v;
}

__device__ __forceinline__ void lds_barrier() { asm volatile("s_waitcnt lgkmcnt(0)" ::: "memory"); __builtin_amdgcn_s_barrier(); asm volatile("" ::: "memory"); }
#define XB_TMO      128
#define XB_XCNT(j)  (256  + 64 * (j))
#define XB_XSUB(j)  (1280 + 64 * (j))
#define XB_XGEN(j)  (2304 + 64 * (j))
#define XB_TOP      3328
#define XB_TOPGEN   3392
#define XCD_BAR_WORDS 3456
#define XB_SPIN_CAP (1u << 18)
__device__ __forceinline__ unsigned xb_ld(unsigned* p)              { return __hip_atomic_load(p, __ATOMIC_RELAXED, __HIP_MEMORY_SCOPE_AGENT); }
__device__ __forceinline__ unsigned xb_add(unsigned* p, unsigned v) { return __hip_atomic_fetch_add(p, v, __ATOMIC_RELAXED, __HIP_MEMORY_SCOPE_AGENT); }
__device__ __forceinline__ unsigned xb_xcc_id() { return (unsigned)__builtin_amdgcn_s_getreg((3 << 11) | 20) & 0xFu; }
#define XB_SPIN(cond, bar) do { unsigned _sp = 0; while (cond) { __builtin_amdgcn_s_sleep(1); \
    if ((++_sp & 255u) == 0u) { if (xb_ld(&(bar)[XB_TMO])) break; if (_sp > XB_SPIN_CAP) { atomicAdd(&(bar)[XB_TMO], 1u); break; } } } } while (0)
struct XcdBarrier { unsigned* bar; unsigned x; volatile LAS unsigned* st; };
__device__ __forceinline__ XcdBarrier xcd_barrier_post(unsigned* bar, volatile LAS unsigned* st) {
    XcdBarrier b; b.bar = bar; b.x = xb_xcc_id(); b.st = st;
    if (threadIdx.x == 0) (void)xb_add(&bar[XB_XCNT(b.x)], 1u);
    return b;
}
__device__ __forceinline__ void xcd_barrier_complete(unsigned* bar, unsigned x, unsigned& nloc, unsigned& nx) {
    const unsigned G = gridDim.x * gridDim.y * gridDim.z;
    unsigned sum, cnt, mine, sp = 0u;
    for (;;) {
        sum = 0u; cnt = 0u; mine = 0u;
#pragma unroll
        for (unsigned j = 0; j < 16; ++j) { const unsigned c = xb_ld(&bar[XB_XCNT(j)]); sum += c; cnt += (c > 0u) ? 1u : 0u; mine = (j == x) ? c : mine; }
        if (sum == G) break;
        __builtin_amdgcn_s_sleep(1);
        if ((++sp & 255u) == 0u) { if (xb_ld(&bar[XB_TMO])) break; if (sp > XB_SPIN_CAP) { atomicAdd(&bar[XB_TMO], 1u); break; } }
    }
    nloc = mine > 0u ? mine : 1u; nx = cnt > 0u ? cnt : 1u;
}
__device__ __forceinline__ void xcd_barrier(const XcdBarrier& b) {
    asm volatile("s_waitcnt vmcnt(0)" ::: "memory");
    __syncthreads();
    if (threadIdx.x == 0) {
        unsigned* bar = b.bar;
        __builtin_amdgcn_s_waitcnt(0);
        unsigned nloc = b.st[0], nx = b.st[1];
        if (nloc == 0u) { xcd_barrier_complete(bar, b.x, nloc, nx); b.st[0] = nloc; b.st[1] = nx; }
        const unsigned old = xb_add(&bar[XB_XSUB(b.x)], 1u);
        const unsigned gen = old / nloc;
        if (old + 1u == (gen + 1u) * nloc) {
            __builtin_amdgcn_fence(__ATOMIC_RELEASE, "agent");
            asm volatile("s_waitcnt vmcnt(0)" ::: "memory");
            const unsigned og = xb_add(&bar[XB_TOP], 1u);
            const unsigned tg = og / nx;
            if (og + 1u == (tg + 1u) * nx) xb_add(&bar[XB_TOPGEN], 1u);
            else XB_SPIN(xb_ld(&bar[XB_TOPGEN]) == tg, bar);
            __builtin_amdgcn_fence(__ATOMIC_ACQUIRE, "agent");
            xb_add(&bar[XB_XGEN(b.x)], 1u);
            asm volatile("s_waitcnt vmcnt(0)" ::: "memory");
        } else {
            XB_SPIN(xb_ld(&bar[XB_XGEN(b.x)]) == gen, bar);
            __builtin_amdgcn_fence(__ATOMIC_ACQUIRE, "agent");
            asm volatile("s_waitcnt vmcnt(0)" ::: "memory");
        }
    }
    __syncthreads();
}

namespace pg8 {
constexpr int BM = 256, BK = 64, HALF = 128, HTB = HALF * BK * 2, STAGE_BYTES = 8 * HTB, NXCD = 8, WGM = 8;
__host__ __device__ __forceinline__ int lds_byte(int r, int c) { const int st = (r >> 4) * 2 + (c >> 5), rr = r & 15, cc = c & 31, ob = rr * 64 + cc * 2; return st * 1024 + (ob ^ (((ob >> 9) & 1) << 5)); }
__host__ __device__ __forceinline__ void stage_rc(int b, int& R, int& C) { const int st = b / 1024, sb = b % 1024, swz = sb ^ (((sb >> 9) & 1) << 5); R = (st >> 1) * 16 + swz / 64; C = (st & 1) * 32 + (swz % 64) / 2; }
__host__ __device__ __forceinline__ int perm32(int rho) { const int n = rho >> 4, i = rho & 15; return 8 * (i >> 2) + 4 * n + (i & 3); }
struct Unit { int pm, pn, pc, hf; };
struct Gemm { const bf16_t* A; const bf16_t* Bt; int K; };
struct StaticOrder {
    int nM, nMf, nN, nwgF, nwg, G, c;
    __device__ void init(int M, int N, int G_, int c_, int Mfull = -1) { nM = M / BM; nMf = (Mfull < 0 ? M : Mfull) / BM; nN = N / BM; nwgF = nMf * nN; nwg = nwgF + 2 * (nM - nMf) * nN; G = G_; c = c_; }
    __device__ bool next(int i, Unit& u) const {
        const long L = (long)i * G + c; if (L >= nwg) return false;
        if (L < nwgF) {
            int wgid = (int)L; { const int q = nwgF / NXCD, r = nwgF % NXCD, xcd = wgid % NXCD, off = wgid / NXCD; wgid = (xcd < r ? xcd * (q + 1) : r * (q + 1) + (xcd - r) * q) + off; }
            const int nig = WGM * nN, gid = wgid / nig, fm = gid * WGM, gsz = (nMf - fm) < WGM ? (nMf - fm) : WGM;
            u.pm = fm + ((wgid % nig) % gsz); u.pn = (wgid % nig) / gsz; u.hf = 0;
        } else { const int r = (int)L - nwgF, xcd = r % NXCD, j = r / NXCD, nT2 = 2 * (nM - nMf), perX = (nwg - nwgF) / NXCD, idx = xcd * perX + j;
            u.pn = idx / nT2; u.pm = nMf + ((idx % nT2) >> 1); u.hf = 1 + (idx & 1); }
        u.pc = u.pn; return true;
    }
    __device__ __forceinline__ void a_ready(const Unit&) const {}
    __device__ __forceinline__ void done(const Unit&) const {}
};
template <int CN0>
struct StaticOrderTailCols {
    int nM, nMf, nN, nwgF, nwg, G, c;
    __device__ void init(int M, int N, int G_, int c_, int Mfull) { nM = M / BM; nMf = Mfull / BM; nN = N / BM; nwgF = nMf * nN; nwg = nwgF + (nM - nMf) * (nN - CN0); G = G_; c = c_; }
    __device__ bool next(int i, Unit& u) const {
        const long L = (long)i * G + c; if (L >= nwg) return false;
        if (L < nwgF) {
            int wgid = (int)L; { const int q = nwgF / NXCD, r = nwgF % NXCD, xcd = wgid % NXCD, off = wgid / NXCD; wgid = (xcd < r ? xcd * (q + 1) : r * (q + 1) + (xcd - r) * q) + off; }
            const int nig = WGM * nN, gid = wgid / nig, fm = gid * WGM, gsz = (nMf - fm) < WGM ? (nMf - fm) : WGM;
            u.pm = fm + ((wgid % nig) % gsz); u.pn = (wgid % nig) / gsz;
        } else { const int r = (int)L - nwgF, nT = nM - nMf; u.pm = nMf + r % nT; u.pn = CN0 + r / nT; }
        u.pc = u.pn; u.hf = 0; return true;
    }
    __device__ __forceinline__ void a_ready(const Unit&) const {}
    __device__ __forceinline__ void done(const Unit&) const {}
};
struct MoeOrder {
    int RT, RTf, CT, nwg, G, c;
    __device__ void init(int RT_, int CT_, int G_, int c_, int RTf_ = -1) { RT = RT_; RTf = RTf_ < 0 ? RT_ : RTf_; CT = CT_; nwg = NE * RT * CT; G = G_; c = c_; }
    __device__ bool next(int i, Unit& u) const {
        const long L0 = (long)i * G + c; if (L0 >= nwg) return false;
        int L = (int)L0; { const int q = nwg / NXCD, r = nwg % NXCD, xcd = L % NXCD, off = L / NXCD; L = (xcd < r ? xcd * (q + 1) : r * (q + 1) + (xcd - r) * q) + off; }
        const int per = RT * CT, e = L / per, rem = L % per, pnl = rem / RT, pml = rem % RT;
        u.pm = e * RT + pml; u.pn = e * CT + pnl; u.pc = pnl; u.hf = pml >= RTf ? 1 : 0; return true;
    }
    __device__ __forceinline__ void a_ready(const Unit&) const {}
    __device__ __forceinline__ void done(const Unit&) const {}
};

template <class Epi, class Sched, bool GATHER = false>
__device__ __forceinline__ void gemm_phase(LAS unsigned char* lds, const Gemm g, const Sched& S, const Epi& E, const int* src = nullptr) {
    const int tid = threadIdx.x, wid = __builtin_amdgcn_readfirstlane(tid >> 6), lane = tid & 63, wr = wid >> 2, wc = wid & 3, fr = lane & 15, fq = lane >> 4;
    const int K = g.K, nt = K / BK;
    unsigned voffA[2][2], voffN[2][2], voffB[2];
    int stR[2], stC[2];
#pragma unroll
    for (int i = 0; i < 2; ++i) { int R, C; stage_rc(tid * 16 + i * 8192, R, C); stR[i] = R; stC[i] = C; const int Rb = Epi::PERM ? ((R & ~31) + perm32(R & 31)) : R;
        voffA[0][i] = (unsigned)(R * K + C) * 2u; voffA[1][i] = voffA[0][i]; voffN[0][i] = voffA[0][i]; voffN[1][i] = voffA[0][i]; voffB[i] = (unsigned)(Rb * K + C) * 2u; }
    const size_t kstep = (size_t)(BK * 2);
    const size_t hstep = (size_t)HALF * K * 2;
    const size_t tstep = 2 * hstep;
    const size_t hstepA = GATHER ? 0 : hstep;
    const unsigned ldsw = (unsigned)wid * 1024u;
    const int aoff = lds_byte(wr * 64 + fr, fq * 8), boff = lds_byte(wc * 32 + fr, fq * 8);
#define PG8_SA(b, h) (((b) * 2 + (h)) * HTB)
#define PG8_SB(b, h) ((4 + (b) * 2 + (h)) * HTB)
#define PG8_STAGE(bufoff, gbase, voff) do { _Pragma("unroll") for (int _i = 0; _i < 2; ++_i) \
        __builtin_amdgcn_global_load_lds((const unsigned*)((const char*)(gbase) + (voff)[_i]), (LAS unsigned*)(lds + (bufoff) + ldsw + _i * 8192), 16, 0, 0); } while (0)
#define PG8_GOFF(dst, pmv) do { if (GATHER) { _Pragma("unroll") for (int _h = 0; _h < 2; ++_h) _Pragma("unroll") for (int _i = 0; _i < 2; ++_i) \
        dst[_h][_i] = ((unsigned)src[(pmv) * BM + _h * HALF + stR[_i]] * (unsigned)K + (unsigned)stC[_i]) * 2u; } } while (0)
#define PG8_LDA(dst, b, h) do { _Pragma("unroll") for (int m = 0; m < 4; ++m) _Pragma("unroll") for (int k = 0; k < 2; ++k) dst[m][k] = *(const LAS bf16x8*)(lds + PG8_SA(b, h) + aoff + m * 2048 + k * 1024); } while (0)
#define PG8_LDB(dst, b, h) do { _Pragma("unroll") for (int n = 0; n < 2; ++n) _Pragma("unroll") for (int k = 0; k < 2; ++k) dst[n][k] = *(const LAS bf16x8*)(lds + PG8_SB(b, h) + boff + n * 2048 + k * 1024); } while (0)
#define PG8_MMA(ai, bj, At, Bt) do { __builtin_amdgcn_s_setprio(1); _Pragma("unroll") for (int m = 0; m < 4; ++m) _Pragma("unroll") for (int n = 0; n < 2; ++n) _Pragma("unroll") for (int k = 0; k < 2; ++k) \
        acc[ai][bj][m][n] = __builtin_amdgcn_mfma_f32_16x16x32_bf16(Bt[n][k], At[m][k], acc[ai][bj][m][n], 0, 0, 0); __builtin_amdgcn_s_setprio(0); } while (0)
#define PG8_WAIT_V(n) asm volatile("s_waitcnt vmcnt(" #n ")" ::: "memory")
#define PG8_WAIT_L(n) asm volatile("s_waitcnt lgkmcnt(" #n ")" ::: "memory")
#define PG8_BAR __builtin_amdgcn_s_barrier()
#define PG8_SCHED __builtin_amdgcn_sched_barrier(0)
    Unit cur, nxt; int ui = 0;
    if (!S.next(0, cur)) return;
    f32x4 acc[2][2][4][2];
#pragma unroll
    for (int a = 0; a < 2; ++a)
#pragma unroll
        for (int b = 0; b < 2; ++b)
#pragma unroll
            for (int m = 0; m < 4; ++m)
#pragma unroll
                for (int n = 0; n < 2; ++n) acc[a][b][m][n] = (f32x4){0.f, 0.f, 0.f, 0.f};
    bf16x8 At[4][2], B0[2][2], B1[2][2];
#define PG8_ABASE(u) ((const char*)g.A + (GATHER ? (size_t)0 : (size_t)(u).pm * tstep + ((u).hf == 2 ? hstep : (size_t)0)))
    const char* cA = PG8_ABASE(cur); const char* cB = (const char*)g.Bt + (size_t)cur.pn * tstep;
    size_t cHA = cur.hf ? (size_t)0 : hstepA; bool full = cur.hf == 0;
    PG8_GOFF(voffA, cur.pm);
    S.a_ready(cur);
    PG8_STAGE(PG8_SB(0, 0), cB, voffB); PG8_STAGE(PG8_SA(0, 0), cA, voffA[0]); PG8_STAGE(PG8_SB(0, 1), cB + hstep, voffB); PG8_STAGE(PG8_SA(0, 1), cA + cHA, voffA[1]);
    if (wr == 1) PG8_BAR;
    PG8_WAIT_V(4); PG8_BAR;
    PG8_STAGE(PG8_SB(1, 0), cB + kstep, voffB); PG8_STAGE(PG8_SA(1, 0), cA + kstep, voffA[0]); PG8_STAGE(PG8_SB(1, 1), cB + hstep + kstep, voffB);
    PG8_WAIT_V(6); PG8_BAR;
    for (;;) {
        const bool has_next = S.next(ui + 1, nxt);
        const size_t nHA = has_next ? (nxt.hf ? (size_t)0 : hstepA) : cHA;
        const char* nA = (has_next && !GATHER) ? PG8_ABASE(nxt) : cA; const char* nB = has_next ? (const char*)g.Bt + (size_t)nxt.pn * tstep : cB;
        if (GATHER) { if (has_next) PG8_GOFF(voffN, nxt.pm); else {
#pragma unroll
            for (int _h = 0; _h < 2; ++_h)
#pragma unroll
                for (int _i = 0; _i < 2; ++_i) voffN[_h][_i] = voffA[_h][_i]; } }
        for (int t = 0; t < nt; t += 2) {
            const bool last = (t == nt - 2);
            const char* a1 = cA + (size_t)(t + 1) * kstep;
            const char* a2 = last ? nA : cA + (size_t)(t + 2) * kstep; const char* b2 = last ? nB : cB + (size_t)(t + 2) * kstep;
            const char* a3 = a2 + kstep; const char* b3 = b2 + kstep;
            unsigned va2[2][2];
#pragma unroll
            for (int _h = 0; _h < 2; ++_h)
#pragma unroll
                for (int _i = 0; _i < 2; ++_i) va2[_h][_i] = (GATHER && last) ? voffN[_h][_i] : voffA[_h][_i];
            if (last && has_next) S.a_ready(nxt);
            PG8_LDB(B0, 0, 0); PG8_SCHED; PG8_LDA(At, 0, 0); PG8_STAGE(PG8_SA(1, 1), a1 + cHA, voffA[1]);
            PG8_WAIT_L(8); PG8_BAR; PG8_WAIT_L(0); PG8_MMA(0, 0, At, B0); PG8_BAR; PG8_SCHED;
            PG8_LDB(B1, 0, 1); PG8_STAGE(PG8_SB(0, 0), b2, voffB);
            PG8_BAR; PG8_WAIT_L(0); PG8_MMA(0, 1, At, B1); PG8_BAR;
            if (full) PG8_LDA(At, 0, 1); PG8_STAGE(PG8_SA(0, 0), a2, va2[0]);
            PG8_BAR; PG8_WAIT_L(0); if (full) PG8_MMA(1, 0, At, B0); PG8_BAR; PG8_SCHED;
            PG8_STAGE(PG8_SB(0, 1), b2 + hstep, voffB);
            PG8_WAIT_V(6); PG8_BAR; if (full) PG8_MMA(1, 1, At, B1); PG8_BAR;
            PG8_LDB(B0, 1, 0); PG8_SCHED; PG8_LDA(At, 1, 0); PG8_STAGE(PG8_SA(0, 1), a2 + (last ? nHA : cHA), va2[1]);
            PG8_WAIT_L(8); PG8_BAR; PG8_WAIT_L(0); PG8_MMA(0, 0, At, B0); PG8_BAR; PG8_SCHED;
            PG8_LDB(B1, 1, 1); PG8_STAGE(PG8_SB(1, 0), b3, voffB);
            PG8_BAR; PG8_WAIT_L(0); PG8_MMA(0, 1, At, B1); PG8_BAR;
            if (full) PG8_LDA(At, 1, 1); PG8_STAGE(PG8_SA(1, 0), a3, va2[0]);
            PG8_BAR; PG8_WAIT_L(0); if (full) PG8_MMA(1, 0, At, B0); PG8_BAR; PG8_SCHED;
            PG8_STAGE(PG8_SB(1, 1), b3 + hstep, voffB);
            PG8_WAIT_V(6); PG8_BAR; if (full) PG8_MMA(1, 1, At, B1); PG8_BAR;
        }
        E(acc, cur, wr, wc, fr, fq); S.done(cur);
        if (!has_next) break;
#pragma unroll
        for (int a = 0; a < 2; ++a)
#pragma unroll
            for (int b = 0; b < 2; ++b)
#pragma unroll
                for (int m = 0; m < 4; ++m)
#pragma unroll
                    for (int n = 0; n < 2; ++n) acc[a][b][m][n] = (f32x4){0.f, 0.f, 0.f, 0.f};
        cur = nxt; cA = nA; cB = nB; cHA = nHA; full = cur.hf == 0; ++ui;
        if (GATHER) {
#pragma unroll
            for (int _h = 0; _h < 2; ++_h)
#pragma unroll
                for (int _i = 0; _i < 2; ++_i) voffA[_h][_i] = voffN[_h][_i]; }
    }
    PG8_WAIT_V(0);
    if (wr == 0) PG8_BAR;
    PG8_BAR;
#undef PG8_SA
#undef PG8_SB
#undef PG8_STAGE
#undef PG8_GOFF
#undef PG8_ABASE
#undef PG8_LDA
#undef PG8_LDB
#undef PG8_MMA
#undef PG8_WAIT_V
#undef PG8_WAIT_L
#undef PG8_BAR
#undef PG8_SCHED
}

struct BSrcF32 { const float* b0; const float* b1; int CT, cstep, hoff; };
template <class Epi, class Sched, bool GATHER, bool HALFU = false>
__device__ __forceinline__ void gemm_phase_fb(LAS unsigned char* lds, const Gemm g, const BSrcF32 bs, const Sched& S, const Epi& E, const int* src = nullptr) {
    static_assert(Epi::PERM, "gemm_phase_fb: permuted weight columns only");
    const int tid = threadIdx.x, wid = __builtin_amdgcn_readfirstlane(tid >> 6), lane = tid & 63, wr = wid >> 2, wc = wid & 3, fr = lane & 15, fq = lane >> 4;
    const int K = g.K, nt = K / BK;
    unsigned voffA[2][2], voffN[2][2];
#pragma unroll
    for (int i = 0; i < 2; ++i) { int R, C; stage_rc(tid * 16 + i * 8192, R, C);
        voffA[0][i] = (unsigned)(R * K + C) * 2u; voffA[1][i] = voffA[0][i]; voffN[0][i] = voffA[0][i]; voffN[1][i] = voffA[0][i]; }
    const size_t kstep = (size_t)(BK * 2);
    const size_t hstep = (size_t)HALF * K * 2;
    const size_t tstep = 2 * hstep;
    const size_t hstepA = GATHER ? 0 : hstep;
    const size_t kstepB = (size_t)BK * 2048 * 4;
    const unsigned ldsw = (unsigned)wid * 1024u;
    const int aoff = lds_byte(wr * 64 + fr, fq * 8);
    const unsigned gvoff = (unsigned)(((tid >> 5) * 2048 + (tid & 31) * 4) * 4);
    unsigned bwoff;
    { const int k0 = tid >> 5, c = 4 * (tid & 31), c5 = c & 31, cp = (c & ~31) + 16 * ((c5 >> 2) & 1) + 4 * (c5 >> 3);
        const int X = ((k0 & 3) << 2) | ((k0 >> 2) & 3); bwoff = (unsigned)(256 * k0 + 16 * ((cp >> 3) ^ X) + 8 * ((cp >> 2) & 1)); }
    const unsigned bwaddr = (unsigned)(size_t)lds + 4 * HTB + bwoff;
    unsigned braddr[2][2];
#pragma unroll
    for (int t = 0; t < 2; ++t) { const int row = 8 * fq + 4 * t + (fr >> 2), X_ = ((row & 3) << 2) | ((row >> 2) & 3), ch = 2 * (2 * wc) + ((lane & 3) >> 1);
        const unsigned o = (unsigned)(256 * row + 16 * (ch ^ X_) + 8 * (lane & 1));
        braddr[t][0] = (unsigned)(size_t)lds + 4 * HTB + o; braddr[t][1] = (unsigned)(size_t)lds + 4 * HTB + (o ^ 32u); }
#define PG8_SA(b, h) (((b) * 2 + (h)) * HTB)
#define PG8_SB(b, h) ((4 + (b) * 2 + (h)) * HTB)
#define PG8_STAGE(bufoff, gbase, voff) do { _Pragma("unroll") for (int _i = 0; _i < 2; ++_i) \
        __builtin_amdgcn_global_load_lds((const unsigned*)((const char*)(gbase) + (voff)[_i]), (LAS unsigned*)(lds + (bufoff) + ldsw + _i * 8192), 16, 0, 0); } while (0)
#define PG8_GOFF(dst, pmv) do { if (GATHER) { _Pragma("unroll") for (int _h = 0; _h < 2; ++_h) _Pragma("unroll") for (int _i = 0; _i < 2; ++_i) { int _R, _C; stage_rc(tid * 16 + _i * 8192, _R, _C); \
        dst[_h][_i] = ((unsigned)src[(pmv) * BM + _h * HALF + _R] * (unsigned)K + (unsigned)_C) * 2u; } } } while (0)
#define PG8_BGL(dst, gbase) do { _Pragma("unroll") for (int _i = 0; _i < 4; ++_i) { const char* _b = (const char*)(gbase) + _i * 131072; \
        asm volatile("global_load_dwordx4 %0, %1, %2" : "=v"(dst[_i]) : "v"(gvoff), "s"(_b) : "memory"); } } while (0)
#define PG8_WAIT_VX(n, r) asm volatile("s_waitcnt vmcnt(" #n ")" : "+v"(r[0]), "+v"(r[1]), "+v"(r[2]), "+v"(r[3]) :: "memory")
#define PG8_BWR(srcv, b, h) do { _Pragma("unroll") for (int _i = 0; _i < 4; ++_i) { u32x2 _w; _w.x = pk2(srcv[_i][0], srcv[_i][1]); _w.y = pk2(srcv[_i][2], srcv[_i][3]); \
        asm volatile("ds_write_b64 %0, %1 offset:%2" :: "v"(bwaddr), "v"(_w), "n"(((b) * 2 + (h)) * HTB + _i * 4096) : "memory"); } } while (0)
#define PG8_LDA(dst, b, h) do { _Pragma("unroll") for (int m = 0; m < 4; ++m) _Pragma("unroll") for (int k = 0; k < 2; ++k) dst[m][k] = *(const LAS bf16x8*)(lds + PG8_SA(b, h) + aoff + m * 2048 + k * 1024); } while (0)
#define PG8_LDB(dst, b, h) do { _Pragma("unroll") for (int n = 0; n < 2; ++n) _Pragma("unroll") for (int k = 0; k < 2; ++k) { s16x4 _lo, _hi; \
            asm volatile("ds_read_b64_tr_b16 %0, %1 offset:%2" : "=v"(_lo) : "v"(braddr[0][n]), "n"(((b) * 2 + (h)) * HTB + k * 8192) : "memory"); \
            asm volatile("ds_read_b64_tr_b16 %0, %1 offset:%2" : "=v"(_hi) : "v"(braddr[1][n]), "n"(((b) * 2 + (h)) * HTB + k * 8192) : "memory"); \
            dst[n][k] = __builtin_shufflevector(_lo, _hi, 0, 1, 2, 3, 4, 5, 6, 7); } } while (0)
#define PG8_WAIT_LB(Bx) asm volatile("s_waitcnt lgkmcnt(0)" : "+v"(Bx[0][0]), "+v"(Bx[0][1]), "+v"(Bx[1][0]), "+v"(Bx[1][1]) :: "memory")
#define PG8_MMA(ai, bj, At, Bt) do { __builtin_amdgcn_s_setprio(1); _Pragma("unroll") for (int m = 0; m < 4; ++m) _Pragma("unroll") for (int n = 0; n < 2; ++n) _Pragma("unroll") for (int k = 0; k < 2; ++k) \
        acc[ai][bj][m][n] = __builtin_amdgcn_mfma_f32_16x16x32_bf16(Bt[n][k], At[m][k], acc[ai][bj][m][n], 0, 0, 0); __builtin_amdgcn_s_setprio(0); } while (0)
#define PG8_WAIT_V(n) asm volatile("s_waitcnt vmcnt(" #n ")" ::: "memory")
#define PG8_WAIT_L(n) asm volatile("s_waitcnt lgkmcnt(" #n ")" ::: "memory")
#define PG8_BAR __builtin_amdgcn_s_barrier()
#define PG8_SCHED __builtin_amdgcn_sched_barrier(0)
#define PG8_BPTR(dst, u) do { const float* _e0 = bs.b0 + (size_t)((u).pn / bs.CT) * 2048 * 2048 + (size_t)(u).pc * bs.cstep; const float* _e1 = bs.b1 + (size_t)((u).pn / bs.CT) * 2048 * 2048 + (size_t)(u).pc * bs.cstep + bs.hoff; \
        dst[0] = (const char*)_e0; dst[1] = (const char*)_e1; } while (0)
    Unit cur, nxt; int ui = 0;
    if (!S.next(0, cur)) return;
    f32x4 acc[2][2][4][2];
#pragma unroll
    for (int a = 0; a < 2; ++a)
#pragma unroll
        for (int b = 0; b < 2; ++b)
#pragma unroll
            for (int m = 0; m < 4; ++m)
#pragma unroll
                for (int n = 0; n < 2; ++n) acc[a][b][m][n] = (f32x4){0.f, 0.f, 0.f, 0.f};
    bf16x8 At[4][2], B0[2][2], B1[2][2];
    f32x4 X[4];
#define PG8_ABASE(u) ((const char*)g.A + (GATHER ? (size_t)0 : (size_t)(u).pm * tstep + ((u).hf == 2 ? hstep : (size_t)0)))
    const char* cA = PG8_ABASE(cur);
    size_t cHA = (HALFU && cur.hf) ? (size_t)0 : hstepA; bool full = !HALFU || cur.hf == 0;
    const char* cB[2]; PG8_BPTR(cB, cur);
    PG8_GOFF(voffA, cur.pm);
    S.a_ready(cur);
    PG8_STAGE(PG8_SA(0, 0), cA, voffA[0]); PG8_STAGE(PG8_SA(0, 1), cA + cHA, voffA[1]);
    PG8_BGL(X, cB[0]); PG8_WAIT_VX(0, X); PG8_BWR(X, 0, 0);
    PG8_BGL(X, cB[1]); PG8_WAIT_VX(0, X); PG8_BWR(X, 0, 1);
    if (wr == 1) PG8_BAR;
    PG8_BGL(X, cB[0] + kstepB); PG8_WAIT_VX(0, X); PG8_BWR(X, 1, 0);
    PG8_WAIT_L(0); PG8_BAR;
    PG8_STAGE(PG8_SA(1, 0), cA + kstep, voffA[0]); PG8_BGL(X, cB[1] + kstepB);
    PG8_BAR;
    for (;;) {
        const bool has_next = S.next(ui + 1, nxt);
        const size_t nHA = (HALFU && has_next) ? (nxt.hf ? (size_t)0 : hstepA) : cHA;
        const char* nA = (has_next && !GATHER) ? PG8_ABASE(nxt) : cA;
        const char* nB[2]; nB[0] = cB[0]; nB[1] = cB[1]; if (has_next) PG8_BPTR(nB, nxt);
        if (GATHER) { if (has_next) PG8_GOFF(voffN, nxt.pm); else {
#pragma unroll
            for (int _h = 0; _h < 2; ++_h)
#pragma unroll
                for (int _i = 0; _i < 2; ++_i) voffN[_h][_i] = voffA[_h][_i]; } }
        for (int t = 0; t < nt; t += 2) {
            const bool last = (t == nt - 2);
            const char* a1 = cA + (size_t)(t + 1) * kstep;
            const char* a2 = last ? nA : cA + (size_t)(t + 2) * kstep;
            const char* a3 = a2 + kstep;
            const char* b20 = last ? nB[0] : cB[0] + (size_t)(t + 2) * kstepB; const char* b21 = last ? nB[1] : cB[1] + (size_t)(t + 2) * kstepB;
            unsigned va2[2][2];
#pragma unroll
            for (int _h = 0; _h < 2; ++_h)
#pragma unroll
                for (int _i = 0; _i < 2; ++_i) va2[_h][_i] = (GATHER && last) ? voffN[_h][_i] : voffA[_h][_i];
            if (last && has_next) S.a_ready(nxt);
            PG8_LDB(B0, 0, 0); PG8_SCHED; PG8_LDA(At, 0, 0); PG8_STAGE(PG8_SA(1, 1), a1 + cHA, voffA[1]);
            PG8_WAIT_L(8); PG8_BAR; PG8_WAIT_LB(B0); PG8_MMA(0, 0, At, B0); PG8_BAR; PG8_SCHED;
            PG8_WAIT_VX(2, X); PG8_BWR(X, 1, 1);
            PG8_LDB(B1, 0, 1); PG8_BGL(X, b20);
            PG8_BAR; PG8_WAIT_LB(B1); PG8_MMA(0, 1, At, B1); PG8_BAR;
            if (full) PG8_LDA(At, 0, 1); PG8_STAGE(PG8_SA(0, 0), a2, va2[0]);
            PG8_BAR; PG8_WAIT_L(0); if (full) PG8_MMA(1, 0, At, B0); PG8_BAR; PG8_SCHED;
            PG8_WAIT_VX(2, X); PG8_BWR(X, 0, 0);
            PG8_BGL(X, b21);
            PG8_WAIT_L(0); PG8_BAR; if (full) PG8_MMA(1, 1, At, B1); PG8_BAR;
            PG8_LDB(B0, 1, 0); PG8_SCHED; PG8_LDA(At, 1, 0); PG8_STAGE(PG8_SA(0, 1), a2 + (last ? nHA : cHA), va2[1]);
            PG8_WAIT_L(8); PG8_BAR; PG8_WAIT_LB(B0); PG8_MMA(0, 0, At, B0); PG8_BAR; PG8_SCHED;
            PG8_WAIT_VX(2, X); PG8_BWR(X, 0, 1);
            PG8_LDB(B1, 1, 1); PG8_BGL(X, b20 + kstepB);
            PG8_BAR; PG8_WAIT_LB(B1); PG8_MMA(0, 1, At, B1); PG8_BAR;
            if (full) PG8_LDA(At, 1, 1); PG8_STAGE(PG8_SA(1, 0), a3, va2[0]);
            PG8_BAR; PG8_WAIT_L(0); if (full) PG8_MMA(1, 0, At, B0); PG8_BAR; PG8_SCHED;
            PG8_WAIT_VX(2, X); PG8_BWR(X, 1, 0);
            PG8_BGL(X, b21 + kstepB);
            PG8_WAIT_L(0); PG8_BAR; if (full) PG8_MMA(1, 1, At, B1); PG8_BAR;
        }
        { int tz = threadIdx.x; asm volatile("" : "+v"(tz)); const int wz = __builtin_amdgcn_readfirstlane(tz >> 6); E(acc, cur, wz >> 2, wz & 3, tz & 15, (tz & 63) >> 4); } S.done(cur);
        if (!has_next) break;
#pragma unroll
        for (int a = 0; a < 2; ++a)
#pragma unroll
            for (int b = 0; b < 2; ++b)
#pragma unroll
                for (int m = 0; m < 4; ++m)
#pragma unroll
                    for (int n = 0; n < 2; ++n) acc[a][b][m][n] = (f32x4){0.f, 0.f, 0.f, 0.f};
        cur = nxt; cA = nA; cB[0] = nB[0]; cB[1] = nB[1]; cHA = nHA; full = !HALFU || cur.hf == 0; ++ui;
        if (GATHER) {
#pragma unroll
            for (int _h = 0; _h < 2; ++_h)
#pragma unroll
                for (int _i = 0; _i < 2; ++_i) voffA[_h][_i] = voffN[_h][_i]; }
    }
    PG8_WAIT_V(0);
    if (wr == 0) PG8_BAR;
    PG8_BAR;
#undef PG8_SA
#undef PG8_SB
#undef PG8_STAGE
#undef PG8_GOFF
#undef PG8_ABASE
#undef PG8_BGL
#undef PG8_WAIT_VX
#undef PG8_BWR
#undef PG8_LDA
#undef PG8_LDB
#undef PG8_WAIT_LB
#undef PG8_MMA
#undef PG8_WAIT_V
#undef PG8_WAIT_L
#undef PG8_BAR
#undef PG8_SCHED
#undef PG8_BPTR
}

struct EpiStore {
    static constexpr bool PERM = true;
    bf16_t* O; int ldc;
    __device__ __forceinline__ void operator()(const f32x4 (&acc)[2][2][4][2], const Unit& u, int wr, int wc, int fr, int fq) const {
        const int row0 = u.pm * BM + (u.hf == 2 ? HALF : 0) + wr * 64 + fr, col0 = u.pc * BM + wc * 32 + 8 * fq;
#pragma unroll
        for (int ai = 0; ai < 2; ++ai) if (ai == 0 || u.hf == 0)
#pragma unroll
            for (int m = 0; m < 4; ++m) { bf16_t* rowp = O + (size_t)(row0 + ai * HALF + m * 16) * ldc + col0;
#pragma unroll
                for (int bj = 0; bj < 2; ++bj) { const f32x4 v0 = acc[ai][bj][m][0], v1 = acc[ai][bj][m][1];
                    u32x4 w; w.x = pk2(v0[0], v0[1]); w.y = pk2(v0[2], v0[3]); w.z = pk2(v1[0], v1[1]); w.w = pk2(v1[2], v1[3]);
                    *(u32x4*)(rowp + bj * HALF) = w; } }
    }
};
struct EpiSiluMul {
    static constexpr bool PERM = true;
    bf16_t* O;
    __device__ __forceinline__ void operator()(const f32x4 (&acc)[2][2][4][2], const Unit& u, int wr, int wc, int fr, int fq) const {
        const int row0 = u.pm * BM + (u.hf == 2 ? HALF : 0) + wr * 64 + fr, col0 = u.pc * HALF + wc * 32 + 8 * fq;
#pragma unroll
        for (int ai = 0; ai < 2; ++ai) if (ai == 0 || u.hf == 0)
#pragma unroll
            for (int m = 0; m < 4; ++m) { bf16_t* rowp = O + (size_t)(row0 + ai * HALF + m * 16) * D + col0;
                float h[8];
#pragma unroll
                for (int n = 0; n < 2; ++n)
#pragma unroll
                    for (int j = 0; j < 4; ++j) { const float gt = acc[ai][0][m][n][j], up = acc[ai][1][m][n][j]; h[n * 4 + j] = gt * __builtin_amdgcn_rcpf(1.f + __expf(-gt)) * up; }
                u32x4 w; w.x = pk2(h[0], h[1]); w.y = pk2(h[2], h[3]); w.z = pk2(h[4], h[5]); w.w = pk2(h[6], h[7]);
                *(u32x4*)rowp = w; }
    }
};
template <bool XIN_BF16>
struct EpiResid {
    static constexpr bool PERM = true;
    const float* xinLat; const float* xinCtx; bf16_t* X1; const float* g1;
    __device__ __forceinline__ void operator()(const f32x4 (&acc)[2][2][4][2], const Unit& u, int wr, int wc, int fr, int fq) const {
        const int row0 = u.pm * BM + (u.hf == 2 ? HALF : 0) + wr * 64 + fr, col0 = u.pc * BM + wc * 32 + 8 * fq;
        const int mrow = u.pm < 64 ? (u.pm >> 4) : 4;
        f32x4 gv[2][2];
#pragma unroll
        for (int bj = 0; bj < 2; ++bj)
#pragma unroll
            for (int n = 0; n < 2; ++n) gv[bj][n] = *(const f32x4*)(g1 + (size_t)mrow * 12288 + col0 + bj * HALF + 4 * n);
#pragma unroll
        for (int ai = 0; ai < 2; ++ai) if (ai == 0 || u.hf == 0)
#pragma unroll
            for (int m = 0; m < 4; ++m) { const int row = row0 + ai * HALF + m * 16;
                bf16_t* orow = X1 + (size_t)row * D + col0;
#pragma unroll
                for (int bj = 0; bj < 2; ++bj) { f32x4 x0, x1;
                    if (XIN_BF16) { const u32x4 w = *(const u32x4*)(orow + bj * HALF); x0 = (f32x4){bflo(w.x), bfhi(w.x), bflo(w.y), bfhi(w.y)}; x1 = (f32x4){bflo(w.z), bfhi(w.z), bflo(w.w), bfhi(w.w)}; }
                    else { const float* xr = (u.pm < 64 ? xinLat + (size_t)row * D : xinCtx + (size_t)(row - M_LAT) * D) + col0 + bj * HALF; x0 = *(const f32x4*)xr; x1 = *(const f32x4*)(xr + 4); }
                    const f32x4 v0 = x0 + gv[bj][0] * acc[ai][bj][m][0], v1 = x1 + gv[bj][1] * acc[ai][bj][m][1];
                    u32x4 w; w.x = pk2(v0[0], v0[1]); w.y = pk2(v0[2], v0[3]); w.z = pk2(v1[0], v1[1]); w.w = pk2(v1[2], v1[3]);
                    *(u32x4*)(orow + bj * HALF) = w; } }
    }
};
}

struct Args { const float* in[26]; float* out; unsigned char* ws; int lo, hi; };
enum { I_X = 0, I_C, I_CTX, I_CCTX, I_ADAW, I_ADAB, I_NMIX, I_NFFN, I_NFIN, I_EVIN, I_EVOUT, I_GAMMA, I_RETN, I_GMLPN, I_GMLPW, I_GMLPB,
       I_ODIN, I_ODOUT, I_RPB, I_GLAWUP, I_GLABUP, I_GLAN, I_ROUTER, I_WGATE, I_WUP, I_WDOWN };

__device__ __forceinline__ void phase_prologue(const Args& a, LAS unsigned char* lds) {
    const int tid = threadIdx.x;
    if (blockIdx.x == gridDim.x - 1) {
        float* rc = (float*)(a.ws + WS_ROT); float* rs = rc + 2048;
        for (int i = tid; i < 2048; i += 512) { const int pos = i >> 5, f = i & 31; const float freq = exp2f(-(float)f * 0.41524101186092029f); const float ang = (float)pos * freq;
            rc[i] = __cosf(ang); rs[i] = __sinf(ang); }
    }
    { bf16_t* wb = (bf16_t*)(a.ws + WS_GMW);
        for (int i = blockIdx.x * 512 + tid; i < 8 * 128 * 128 / 2; i += gridDim.x * 512) { const f32x2 v = *(const f32x2*)(a.in[I_GMLPW] + 2 * i); ((unsigned*)wb)[i] = pk2(v[0], v[1]); } }
    LAS float* sc = (LAS float*)lds;
    LAS float* red = (LAS float*)(lds + 40960);
    float* MOD = (float*)(a.ws + WS_MOD);
    if ((int)blockIdx.x < 192) {
        for (int i = tid; i < 5 * 2048; i += 512) { const int r = i >> 11, k = i & 2047; const float v = r < 4 ? a.in[I_C][r * 2048 + k] : a.in[I_CCTX][k]; sc[i] = v / (1.f + expf(-v)); }
        __syncthreads();
        const int u = blockIdx.x, l = u / 96, cb = u % 96, cq = tid & 31, kq = tid >> 5;
        const float* w = a.in[I_ADAW] + (size_t)l * 2048 * 12288 + cb * 128 + cq * 4;
        f32x4 acc[5];
#pragma unroll
        for (int r = 0; r < 5; ++r) acc[r] = (f32x4){0.f, 0.f, 0.f, 0.f};
        for (int j0 = 0; j0 < 128; j0 += 16) {
            f32x4 wv[16];
#pragma unroll
            for (int j = 0; j < 16; ++j) wv[j] = *(const f32x4*)(w + (size_t)(kq + 16 * (j0 + j)) * 12288);
            __builtin_amdgcn_sched_barrier(0);
#pragma unroll
            for (int j = 0; j < 16; ++j) { const int k = kq + 16 * (j0 + j);
#pragma unroll
                for (int r = 0; r < 5; ++r) acc[r] += sc[r * 2048 + k] * wv[j]; }
        }
#pragma unroll
        for (int r = 0; r < 5; ++r) *(LAS f32x4*)(red + (kq * 5 + r) * 128 + cq * 4) = acc[r];
        __syncthreads();
        for (int o = tid; o < 640; o += 512) { const int r = o >> 7, cc = o & 127; float s = 0.f;
#pragma unroll
            for (int q = 0; q < 16; ++q) s += red[(q * 5 + r) * 128 + cc];
            MOD[(size_t)(l * 5 + r) * 12288 + cb * 128 + cc] = s + a.in[I_ADAB][l * 12288 + cb * 128 + cc]; }
    }
    LAS float* tile = (LAS float*)lds;
    constexpr int CJ0 = 16 * 48, CJ1 = 16 * 16, CJ2 = 16 * 50, CJ3 = 16 * 16, CJM = 32 * 256;
    constexpr int CTOT = CJ0 + CJ1 + CJ2 + CJ3 + 2 * CJM;
    __syncthreads();
    unsigned* cq_head = (unsigned*)(a.ws + WS_CTL) + 8192 + 768;
    volatile LAS int* qs = (volatile LAS int*)(lds + 128 * 129 * 4);
    int pend = 0, it = 0;
    if (tid == 0) { qs[0] = (int)xb_add(cq_head, 1u); pend = (int)xb_add(cq_head, 1u); }
    __syncthreads();
    for (int u = qs[0]; u < CTOT; u = qs[it & 1]) {
        int r = u; const float* src; int ldn, nvalid, NT, mode = 0; bf16_t* dst;
        if (r < CJ0) { src = a.in[I_EVIN]; ldn = 6144; nvalid = 6144; NT = 48; dst = (bf16_t*)(a.ws + WS_WIN0); }
        else if ((r -= CJ0) < CJ1) { src = a.in[I_EVOUT]; ldn = 2048; nvalid = 2048; NT = 16; dst = (bf16_t*)(a.ws + WS_WOUT0); }
        else if ((r -= CJ1) < CJ2) { src = a.in[I_ODIN]; ldn = 6176; nvalid = 6176; NT = 50; dst = (bf16_t*)(a.ws + WS_WIN1); }
        else if ((r -= CJ2) < CJ3) { src = a.in[I_ODOUT]; ldn = 2048; nvalid = 2048; NT = 16; dst = (bf16_t*)(a.ws + WS_WOUT1); }
        else { r -= CJ3; const int which = r / CJM; r -= which * CJM; const int mtx = r >> 8; r &= 255; ldn = 2048; nvalid = 2048; NT = 16;
            if (which == 0) { src = a.in[I_WGATE] + (size_t)mtx * 2048 * 2048; dst = (bf16_t*)(a.ws + WS_WGU) + (size_t)mtx * 4096 * 2048; mode = 1; }
            else if (which == 1) { src = a.in[I_WUP] + (size_t)mtx * 2048 * 2048; dst = (bf16_t*)(a.ws + WS_WGU) + (size_t)mtx * 4096 * 2048; mode = 2; }
            else { src = a.in[I_WDOWN] + (size_t)mtx * 2048 * 2048; dst = (bf16_t*)(a.ws + WS_WDN) + (size_t)mtx * 2048 * 2048; } }
        const int kt = r / NT, ntl = r % NT, k0 = kt * 128, n0 = ntl * 128;
        const int drow0 = mode == 0 ? n0 : (ntl * 256 + (mode == 2 ? 128 : 0));
        f32x4 v[8];
#pragma unroll
        for (int i = 0; i < 8; ++i) { const int id = tid + 512 * i, row = id >> 5, c4 = id & 31, n = n0 + c4 * 4;
            v[i] = (f32x4){0.f, 0.f, 0.f, 0.f};
            if (n < nvalid) v[i] = *(const f32x4*)(src + (size_t)(k0 + row) * ldn + n); }
#pragma unroll
        for (int i = 0; i < 8; ++i) { const int id = tid + 512 * i, row = id >> 5, c4 = id & 31;
            LAS float* tp = tile + row * 129 + c4 * 4; tp[0] = v[i][0]; tp[1] = v[i][1]; tp[2] = v[i][2]; tp[3] = v[i][3]; }
        lds_barrier();
#pragma unroll
        for (int i = 0; i < 4; ++i) { const int piece = tid + 512 * i, nl = piece >> 4, kg = piece & 15; const LAS float* s = tile + (kg * 8) * 129 + nl;
            u32x4 o; o.x = pk2(s[0], s[129]); o.y = pk2(s[258], s[387]); o.z = pk2(s[516], s[645]); o.w = pk2(s[774], s[903]);
            *(u32x4*)(dst + (size_t)(drow0 + nl) * 2048 + k0 + kg * 8) = o; }
        ++it;
        if (tid == 0) { qs[it & 1] = pend; pend = (int)xb_add(cq_head, 1u); }
        lds_barrier();
    }
}

__device__ __forceinline__ void phase_modnorm(const float* srcLat, const float* srcCtx, int nrows, const float* gain, const float* modl, int sh_off, int sc_off, bf16_t* Hb) {
    const int tid = threadIdx.x, lane = tid & 63, wave = tid >> 6;
    const int RPW = (nrows + (int)gridDim.x - 1) / (int)gridDim.x, rb = blockIdx.x * RPW, re = min(rb + RPW, nrows);
    f32x4 nv[4][2];
    const int r0 = rb + wave;
    if (r0 < re) { const float* xr = r0 < M_LAT ? srcLat + (size_t)r0 * D : srcCtx + (size_t)(r0 - M_LAT) * D;
#pragma unroll
        for (int j = 0; j < 4; ++j) { nv[j][0] = *(const f32x4*)(xr + 8 * (lane + 64 * j)); nv[j][1] = *(const f32x4*)(xr + 8 * (lane + 64 * j) + 4); } }
    f32x4 A[4][2], S[4][2]; int mcur = -1;
    for (int r = r0; r < re; r += 8) {
        const int mrow = r < M_LAT ? (r >> 12) : 4;
        if (mrow != mcur) { mcur = mrow; const float* mr = modl + (size_t)mrow * 12288;
#pragma unroll
            for (int j = 0; j < 4; ++j)
#pragma unroll
                for (int t = 0; t < 2; ++t) { const int k = 8 * (lane + 64 * j) + 4 * t; A[j][t] = *(const f32x4*)(gain + k) * (*(const f32x4*)(mr + sc_off + k) + 1.f); S[j][t] = *(const f32x4*)(mr + sh_off + k); } }
        f32x4 v[4][2]; float ss = 0.f;
#pragma unroll
        for (int j = 0; j < 4; ++j)
#pragma unroll
            for (int t = 0; t < 2; ++t) { v[j][t] = nv[j][t]; ss += (v[j][t][0] * v[j][t][0] + v[j][t][1] * v[j][t][1]) + (v[j][t][2] * v[j][t][2] + v[j][t][3] * v[j][t][3]); }
        const int rn = r + 8;
        if (rn < re) { const float* xn = rn < M_LAT ? srcLat + (size_t)rn * D : srcCtx + (size_t)(rn - M_LAT) * D;
#pragma unroll
            for (int j = 0; j < 4; ++j) { nv[j][0] = *(const f32x4*)(xn + 8 * (lane + 64 * j)); nv[j][1] = *(const f32x4*)(xn + 8 * (lane + 64 * j) + 4); } }
        const float rstd = rsqrtf(wave_sum(ss) * (1.f / D) + EPS);
        bf16_t* orow = Hb + (size_t)r * D;
#pragma unroll
        for (int j = 0; j < 4; ++j) { const f32x4 h0 = v[j][0] * rstd * A[j][0] + S[j][0], h1 = v[j][1] * rstd * A[j][1] + S[j][1];
            u32x4 w; w.x = pk2(h0[0], h0[1]); w.y = pk2(h0[2], h0[3]); w.z = pk2(h1[0], h1[1]); w.w = pk2(h1[2], h1[3]);
            *(u32x4*)(orow + 8 * (lane + 64 * j)) = w; }
    }
}

constexpr int RT_HRS = 4096 + 16, RT_WRS = 4096 + 16;
constexpr int RT_H = 0, RT_W = 16 * RT_HRS, RT_RED = RT_W + 16 * RT_WRS, RT_END = RT_RED + 8 * 1024;
static_assert(RT_END <= LDS_BARW, "router LDS map");
__device__ __forceinline__ void phase_modnorm_router(const bf16_t* X1, int nrows, const float* gain, const float* modl, int sh_off, int sc_off,
                                                     bf16_t* Hb, const float* router_w, float* aff, LAS unsigned char* lds) {
    const int tid = threadIdx.x, lane = tid & 63, wv = __builtin_amdgcn_readfirstlane(tid >> 6);
    const int l15 = lane & 15, q = lane >> 4;
    __syncthreads();
#pragma unroll 4
    for (int i4 = tid; i4 < 2048 * 4; i4 += 512) { const int k = i4 >> 2, e0 = 4 * (i4 & 3); const f32x4 w = *(const f32x4*)(router_w + 4 * i4);
#pragma unroll
        for (int c = 0; c < 4; ++c) *(LAS bf16_t*)(lds + RT_W + (e0 + c) * RT_WRS + k * 2) = (bf16_t)f2bf(w[c]); }
    __syncthreads();
    const int ngroups = nrows / 16;
    u32x4 nxr[2][4];
    const int gb = (int)(((long)blockIdx.x * ngroups) / gridDim.x), ge = (int)(((long)(blockIdx.x + 1) * ngroups) / gridDim.x);
    f32x4 Am[4][2], Sm[4][2]; int mcur = -1;
    if (gb < ge) {
#pragma unroll
        for (int rr = 0; rr < 2; ++rr)
#pragma unroll
            for (int j = 0; j < 4; ++j) nxr[rr][j] = *(const u32x4*)(X1 + (size_t)(gb * 16 + 2 * wv + rr) * D + 8 * (lane + 64 * j)); }
    for (int grp = gb; grp < ge; ++grp) {
        u32x4 cxr[2][4];
#pragma unroll
        for (int rr = 0; rr < 2; ++rr)
#pragma unroll
            for (int j = 0; j < 4; ++j) cxr[rr][j] = nxr[rr][j];
        if (grp + 1 < ge) {
#pragma unroll
            for (int rr = 0; rr < 2; ++rr)
#pragma unroll
                for (int j = 0; j < 4; ++j) nxr[rr][j] = *(const u32x4*)(X1 + (size_t)((grp + 1) * 16 + 2 * wv + rr) * D + 8 * (lane + 64 * j)); }
        { const int mrow = (grp * 16) < M_LAT ? ((grp * 16) >> 12) : 4;
            if (mrow != mcur) { mcur = mrow; const float* mr = modl + (size_t)mrow * 12288;
#pragma unroll
                for (int j = 0; j < 4; ++j)
#pragma unroll
                    for (int t2 = 0; t2 < 2; ++t2) { const int k = 8 * (lane + 64 * j) + 4 * t2; Am[j][t2] = *(const f32x4*)(gain + k) * (*(const f32x4*)(mr + sc_off + k) + 1.f); Sm[j][t2] = *(const f32x4*)(mr + sh_off + k); } } }
#pragma unroll
        for (int rr = 0; rr < 2; ++rr) {
            const int lr = 2 * wv + rr, r = grp * 16 + lr;
            f32x4 v[4][2]; float ss = 0.f;
#pragma unroll
            for (int j = 0; j < 4; ++j) { const u32x4 w = cxr[rr][j];
                v[j][0] = (f32x4){bflo(w.x), bfhi(w.x), bflo(w.y), bfhi(w.y)}; v[j][1] = (f32x4){bflo(w.z), bfhi(w.z), bflo(w.w), bfhi(w.w)};
#pragma unroll
                for (int t2 = 0; t2 < 2; ++t2) ss += (v[j][t2][0] * v[j][t2][0] + v[j][t2][1] * v[j][t2][1]) + (v[j][t2][2] * v[j][t2][2] + v[j][t2][3] * v[j][t2][3]); }
            const float rstd = rsqrtf(wave_sum(ss) * (1.f / D) + EPS);
            bf16_t* orow = Hb + (size_t)r * D;
#pragma unroll
            for (int j = 0; j < 4; ++j) { const int k = 8 * (lane + 64 * j);
                f32x4 hv[2];
#pragma unroll
                for (int t2 = 0; t2 < 2; ++t2) hv[t2] = v[j][t2] * rstd * Am[j][t2] + Sm[j][t2];
                u32x4 w; w.x = pk2(hv[0][0], hv[0][1]); w.y = pk2(hv[0][2], hv[0][3]); w.z = pk2(hv[1][0], hv[1][1]); w.w = pk2(hv[1][2], hv[1][3]);
                *(u32x4*)(orow + k) = w; *(LAS u32x4*)(lds + RT_H + lr * RT_HRS + k * 2) = w; }
        }
        lds_barrier();
        f32x4 acc = (f32x4){0.f, 0.f, 0.f, 0.f};
#pragma unroll
        for (int kk = 0; kk < 8; ++kk) { const int kb = (256 * wv + 32 * kk + 8 * q) * 2;
            const bf16x8 af = *(const LAS bf16x8*)(lds + RT_H + l15 * RT_HRS + kb), bfr = *(const LAS bf16x8*)(lds + RT_W + l15 * RT_WRS + kb);
            acc = __builtin_amdgcn_mfma_f32_16x16x32_bf16(af, bfr, acc, 0, 0, 0); }
        { LAS float* red = (LAS float*)(lds + RT_RED) + wv * 256;
#pragma unroll
            for (int rg = 0; rg < 4; ++rg) red[(4 * q + rg) * 16 + l15] = acc[rg]; }
        lds_barrier();
        if (tid < 256) { const int row = tid >> 4, e = tid & 15; float lg = 0.f;
#pragma unroll
            for (int w = 0; w < 8; ++w) lg += ((const LAS float*)(lds + RT_RED))[w * 256 + tid];
            float mx = lg;
#pragma unroll
            for (int o = 1; o < 16; o <<= 1) mx = fmaxf(mx, __shfl_xor(mx, o));
            const float ex = __expf(lg - mx); float den = ex;
#pragma unroll
            for (int o = 1; o < 16; o <<= 1) den += __shfl_xor(den, o);
            const float p = ex / den; const int r = grp * 16 + row;
            if (r < M_LAT) aff[((size_t)((r >> 12) * NE + e)) * T + (r & 4095)] = p;
            else { const int rc = r - M_LAT; aff[(size_t)NB * NE * T + ((size_t)((rc >> 8) * NE + e)) * CL + (rc & 255)] = p; } }
        lds_barrier();
    }
}

__device__ __forceinline__ int block_excl_scan(int v, LAS int* wsum, int lane, int wave, int& total) {
    int incl = v;
#pragma unroll
    for (int o = 1; o < 64; o <<= 1) { const int t = __shfl_up(incl, o); if (lane >= o) incl += t; }
    __syncthreads();
    if (lane == 63) wsum[wave] = incl;
    __syncthreads();
    int base = 0, tot = 0;
#pragma unroll
    for (int w = 0; w < 8; ++w) { const int s = wsum[w]; tot += s; base += (w < wave) ? s : 0; }
    total = tot;
    return base + incl - v;
}
__device__ __forceinline__ void phase_topk(const float* aff, int* SRC, float* GATE, int* INV, int RPE, bool with_ctx, LAS unsigned char* lds) {
    const int tid = threadIdx.x, lane = tid & 63, wave = tid >> 6;
    LAS int* wsum = (LAS int*)lds;
    LAS int* cnts = (LAS int*)(lds + 64);
    const int nunits = with_ctx ? 128 : 64;
    for (int u = blockIdx.x; u < nunits; u += gridDim.x) {
        const int kind = u >> 6, b = (u >> 4) & 3, e = u & 15;
        const int Tn = kind ? CL : T, cap = Tn / 8;
        const float* av = aff + (kind ? (size_t)NB * NE * T + (size_t)(b * NE + e) * CL : (size_t)(b * NE + e) * T);
        unsigned vb[8];
#pragma unroll
        for (int j = 0; j < 8; ++j) { const int t = tid * 8 + j; vb[j] = t < Tn ? __float_as_uint(av[t]) : 0u; }
        unsigned thr = 0u;
        for (int bit = 30; bit >= 0; --bit) {
            const unsigned cand = thr | (1u << bit);
            int c = 0;
#pragma unroll
            for (int j = 0; j < 8; ++j) c += (vb[j] >= cand) ? 1 : 0;
#pragma unroll
            for (int o = 1; o < 64; o <<= 1) c += __shfl_xor(c, o);
            LAS int* cb = cnts + (bit & 1) * 8;
            if (lane == 0) cb[wave] = c;
            __syncthreads();
            int tot = 0;
#pragma unroll
            for (int w = 0; w < 8; ++w) tot += cb[w];
            if (tot >= cap) thr = cand;
        }
        int ngt_l = 0, neq_l = 0;
#pragma unroll
        for (int j = 0; j < 8; ++j) { ngt_l += (vb[j] > thr) ? 1 : 0; neq_l += (vb[j] == thr) ? 1 : 0; }
        int ngt_tot, neq_tot;
        (void)block_excl_scan(ngt_l, wsum, lane, wave, ngt_tot);
        const int eq_base = block_excl_scan(neq_l, wsum, lane, wave, neq_tot);
        const int need_eq = cap - ngt_tot;
        int sel_l = 0, eqr = eq_base; unsigned selmask = 0u;
#pragma unroll
        for (int j = 0; j < 8; ++j) { bool s = vb[j] > thr; if (vb[j] == thr) { s = eqr < need_eq; ++eqr; } if (vb[j] == 0u) s = false; selmask |= s ? (1u << j) : 0u; sel_l += s ? 1 : 0; }
        int sel_tot;
        int slot = block_excl_scan(sel_l, wsum, lane, wave, sel_tot);
        const int gbase = e * RPE + (kind ? 2048 + b * 32 : b * 512);
        const int rbase = kind ? M_LAT + b * CL : b * T;
#pragma unroll
        for (int j = 0; j < 8; ++j) { const int t = tid * 8 + j;
            if (t < Tn) { int g = -1;
                if (selmask & (1u << j)) { g = gbase + slot; ++slot; SRC[g] = rbase + t; GATE[g] = __uint_as_float(vb[j]); }
                INV[(size_t)(rbase + t) * NE + e] = g; } }
        if (kind == 1 && b == 0 && tid < 128) { SRC[e * RPE + 2176 + tid] = 0; GATE[e * RPE + 2176 + tid] = 0.f; }
        __syncthreads();
    }
}

template <bool LAST>
__device__ __forceinline__ void phase_moe_combine(bf16_t* X1, const bf16_t* Ye, const int* INV, const float* GATE, const float* g2  , int nrows,
                                                  const float* gain, const float* modn, bf16_t* Hb, float* out) {
    const int lane = threadIdx.x & 63, wave = threadIdx.x >> 6;
    const int gw = blockIdx.x * 8 + wave, NGW = gridDim.x * 8;
    u32x4 inv[4], nx[4];
    if (gw < nrows) {
#pragma unroll
        for (int i = 0; i < 4; ++i) { inv[i] = *(const u32x4*)(INV + (size_t)gw * NE + 4 * i); nx[i] = *(const u32x4*)(X1 + (size_t)gw * D + 8 * (lane + 64 * i)); } }
    for (int r = gw; r < nrows; r += NGW) {
        const int mrow = r < M_LAT ? (r >> 12) : 4;
        const unsigned sl[16] = {inv[0].x, inv[0].y, inv[0].z, inv[0].w, inv[1].x, inv[1].y, inv[1].z, inv[1].w, inv[2].x, inv[2].y, inv[2].z, inv[2].w, inv[3].x, inv[3].y, inv[3].z, inv[3].w};
        if (r + NGW < nrows) {
#pragma unroll
            for (int i = 0; i < 4; ++i) inv[i] = *(const u32x4*)(INV + (size_t)(r + NGW) * NE + 4 * i); }
        f32x4 acc[4][2];
#pragma unroll
        for (int j = 0; j < 4; ++j) { acc[j][0] = (f32x4){0.f, 0.f, 0.f, 0.f}; acc[j][1] = (f32x4){0.f, 0.f, 0.f, 0.f}; }
#pragma unroll
        for (int e = 0; e < NE; ++e) {
            const int s = __builtin_amdgcn_readfirstlane((int)sl[e]);
            if (s >= 0) { const float gt = GATE[s]; const bf16_t* yr = Ye + (size_t)s * D;
#pragma unroll
                for (int j = 0; j < 4; ++j) { const u32x4 w = *(const u32x4*)(yr + 8 * (lane + 64 * j));
                    acc[j][0] += (f32x4){bflo(w.x), bfhi(w.x), bflo(w.y), bfhi(w.y)} * gt; acc[j][1] += (f32x4){bflo(w.z), bfhi(w.z), bflo(w.w), bfhi(w.w)} * gt; } }
        }
        bf16_t* xr = X1 + (size_t)r * D; const float* gr = g2 + (size_t)mrow * 12288;
        u32x4 xw_[4];
#pragma unroll
        for (int j = 0; j < 4; ++j) xw_[j] = nx[j];
        if (r + NGW < nrows) {
#pragma unroll
            for (int j = 0; j < 4; ++j) nx[j] = *(const u32x4*)(X1 + (size_t)(r + NGW) * D + 8 * (lane + 64 * j)); }
        f32x4 v[4][2]; float ss = 0.f;
#pragma unroll
        for (int j = 0; j < 4; ++j) { const int k = 8 * (lane + 64 * j); const u32x4 w = xw_[j];
            v[j][0] = (f32x4){bflo(w.x), bfhi(w.x), bflo(w.y), bfhi(w.y)} + *(const f32x4*)(gr + k) * acc[j][0];
            v[j][1] = (f32x4){bflo(w.z), bfhi(w.z), bflo(w.w), bfhi(w.w)} + *(const f32x4*)(gr + k + 4) * acc[j][1];
#pragma unroll
            for (int t2 = 0; t2 < 2; ++t2) ss += (v[j][t2][0] * v[j][t2][0] + v[j][t2][1] * v[j][t2][1]) + (v[j][t2][2] * v[j][t2][2] + v[j][t2][3] * v[j][t2][3]); }
        const float rstd = rsqrtf(wave_sum(ss) * (1.f / D) + EPS);
        if (LAST) {
#pragma unroll
            for (int j = 0; j < 4; ++j) { const int k = 8 * (lane + 64 * j);
                *(f32x4*)(out + (size_t)r * D + k) = v[j][0] * rstd * *(const f32x4*)(gain + k); *(f32x4*)(out + (size_t)r * D + k + 4) = v[j][1] * rstd * *(const f32x4*)(gain + k + 4); }
        } else {
            const float* mr = modn + (size_t)mrow * 12288;
#pragma unroll
            for (int j = 0; j < 4; ++j) { const int k = 8 * (lane + 64 * j);
                u32x4 xw; xw.x = pk2(v[j][0][0], v[j][0][1]); xw.y = pk2(v[j][0][2], v[j][0][3]); xw.z = pk2(v[j][1][0], v[j][1][1]); xw.w = pk2(v[j][1][2], v[j][1][3]);
                *(u32x4*)(xr + k) = xw;
                f32x4 h[2];
#pragma unroll
                for (int t2 = 0; t2 < 2; ++t2) h[t2] = v[j][t2] * rstd * *(const f32x4*)(gain + k + 4 * t2) * (*(const f32x4*)(mr + D + k + 4 * t2) + 1.f) + *(const f32x4*)(mr + k + 4 * t2);
                u32x4 w; w.x = pk2(h[0][0], h[0][1]); w.y = pk2(h[0][2], h[0][3]); w.z = pk2(h[1][0], h[1][1]); w.w = pk2(h[1][2], h[1][3]);
                *(u32x4*)(Hb + (size_t)r * D + k) = w; }
        }
    }
}

__device__ __forceinline__ void phase_head_combine_bf16(const bf16_t* Of, const bf16_t* Ob, const bf16_t* P, int ldp, int gcol, const float* gain, bf16_t* AO, int ocol, int nrows) {
    const int lane = threadIdx.x & 63, wave = threadIdx.x >> 6;
    const int gw = blockIdx.x * 8 + wave, NGW = gridDim.x * 8;
    const int hc = (lane >> 3) * 128 + (lane & 7) * 16;
    u32x4 nf0, nf1, nb0, nb1, ng0, ng1;
#define HC_LOAD(rr) do { const u32x4* pf_ = (const u32x4*)(Of + (size_t)(rr) * 1024 + hc); const u32x4* pb_ = (const u32x4*)(Ob + (size_t)(rr) * 1024 + hc); const u32x4* gp_ = (const u32x4*)(P + (size_t)(rr) * ldp + gcol + hc); \
        nf0 = pf_[0]; nf1 = pf_[1]; nb0 = pb_[0]; nb1 = pb_[1]; ng0 = gp_[0]; ng1 = gp_[1]; } while (0)
    f32x4 gnv[4];
#pragma unroll
    for (int i = 0; i < 4; ++i) gnv[i] = *(const f32x4*)(gain + hc + 4 * i);
    if (gw < nrows) HC_LOAD(gw);
    for (int r = gw; r < nrows; r += NGW) {
        const unsigned fw[8] = {nf0.x, nf0.y, nf0.z, nf0.w, nf1.x, nf1.y, nf1.z, nf1.w}, bw[8] = {nb0.x, nb0.y, nb0.z, nb0.w, nb1.x, nb1.y, nb1.z, nb1.w};
        const unsigned gw_[8] = {ng0.x, ng0.y, ng0.z, ng0.w, ng1.x, ng1.y, ng1.z, ng1.w};
        if (r + NGW < nrows) HC_LOAD(r + NGW);
        f32x4 o[4]; float ss = 0.f;
#pragma unroll
        for (int i = 0; i < 4; ++i) { o[i] = (f32x4){bflo(fw[2 * i]) + bflo(bw[2 * i]), bfhi(fw[2 * i]) + bfhi(bw[2 * i]), bflo(fw[2 * i + 1]) + bflo(bw[2 * i + 1]), bfhi(fw[2 * i + 1]) + bfhi(bw[2 * i + 1])};
            ss += (o[i][0] * o[i][0] + o[i][1] * o[i][1]) + (o[i][2] * o[i][2] + o[i][3] * o[i][3]); }
        ss += __shfl_xor(ss, 1); ss += __shfl_xor(ss, 2); ss += __shfl_xor(ss, 4);
        const float rstd = rsqrtf(ss * (1.f / 128.f) + EPS);
        unsigned ow[8];
#pragma unroll
        for (int i = 0; i < 4; ++i) { const f32x4 gn = gnv[i];
            const float a0 = o[i][0] * rstd * gn[0] * silu_f(bflo(gw_[2 * i])), a1 = o[i][1] * rstd * gn[1] * silu_f(bfhi(gw_[2 * i]));
            const float a2 = o[i][2] * rstd * gn[2] * silu_f(bflo(gw_[2 * i + 1])), a3 = o[i][3] * rstd * gn[3] * silu_f(bfhi(gw_[2 * i + 1]));
            ow[2 * i] = pk2(a0, a1); ow[2 * i + 1] = pk2(a2, a3); }
        u32x4* op = (u32x4*)(AO + (size_t)r * D + ocol + hc);
        op[0] = (u32x4){ow[0], ow[1], ow[2], ow[3]}; op[1] = (u32x4){ow[4], ow[5], ow[6], ow[7]};
    }
#undef HC_LOAD
}

__device__ __forceinline__ bf16x8 tr_frag(LAS unsigned char* p0, int hi_off) {
    const s16x4 lo = __builtin_amdgcn_ds_read_tr16_b64_v4i16((LAS s16x4*)p0);
    const s16x4 hi = __builtin_amdgcn_ds_read_tr16_b64_v4i16((LAS s16x4*)(p0 + hi_off));
    return (bf16x8){lo[0], lo[1], lo[2], lo[3], hi[0], hi[1], hi[2], hi[3]};
}
constexpr int R_RS = 288;
constexpr int RP_KS = 0, RP_V1 = 128 * R_RS, RP_V2 = 2 * 128 * R_RS, RP_ROT = 3 * 128 * R_RS;
static_assert(RP_ROT + 16384 <= LDS_BARW, "parallel retention LDS map");
constexpr int NRC = (CL + T) / 128;
__device__ __forceinline__ int retp_row(int b, int sp) { return sp < CL ? M_LAT + b * CL + sp : b * T + (sp - CL); }
__device__ __forceinline__ void retp_stage_k(const bf16_t* P, int b, int h, int j, LAS unsigned char* lds) {
    const int tid = threadIdx.x;
#pragma unroll
    for (int i = 0; i < 2; ++i) { const int task = tid + 512 * i, p = task >> 3, sec = (task >> 2) & 1, fg = task & 3;
        const int sp = j * 128 + p;
        const bf16_t* pr = P + (size_t)retp_row(b, sp) * LDP0 + 4096 + h * 128 + sec * 64 + 8 * fg;
        const u32x4 r1 = *(const u32x4*)pr, r2 = *(const u32x4*)(pr + 32);
        f32x4 c0 = (f32x4){1.f, 1.f, 1.f, 1.f}, c1 = c0, s0 = (f32x4){0.f, 0.f, 0.f, 0.f}, s1 = s0;
        if (sp >= CL) { const int t = sp - CL; const int pos = sec ? (t & 63) : (t >> 6);
            const LAS f32x4* cp = (const LAS f32x4*)(lds + RP_ROT + (pos * 32 + 8 * fg) * 4); const LAS f32x4* spp = (const LAS f32x4*)(lds + RP_ROT + 8192 + (pos * 32 + 8 * fg) * 4);
            c0 = cp[0]; c1 = cp[1]; s0 = spp[0]; s1 = spp[1]; }
        const float cc[8] = {c0[0], c0[1], c0[2], c0[3], c1[0], c1[1], c1[2], c1[3]}, ss[8] = {s0[0], s0[1], s0[2], s0[3], s1[0], s1[1], s1[2], s1[3]};
        const unsigned k1w[4] = {r1.x, r1.y, r1.z, r1.w}, k2w[4] = {r2.x, r2.y, r2.z, r2.w};
        unsigned o1[4], o2[4];
#pragma unroll
        for (int w = 0; w < 4; ++w) { const float ka0 = bflo(k1w[w]), ka1 = bfhi(k1w[w]), kb0 = bflo(k2w[w]), kb1 = bfhi(k2w[w]);
            const float ce = cc[2 * w], co = cc[2 * w + 1], se = ss[2 * w], so = ss[2 * w + 1];
            o1[w] = pk2(ka0 * ce - kb0 * se, ka1 * co - kb1 * so); o2[w] = pk2(ka0 * se + kb0 * ce, ka1 * so + kb1 * co); }
        const int off = p * R_RS + (sec * 64 + 8 * fg) * 2;
        *(LAS u32x4*)(lds + RP_KS + off) = (u32x4){o1[0], o1[1], o1[2], o1[3]}; *(LAS u32x4*)(lds + RP_KS + off + 64) = (u32x4){o2[0], o2[1], o2[2], o2[3]}; }
}
__device__ __forceinline__ void retp_kv_unit(int unit, const bf16_t* P, const float* rotg, const float* gamma_logit, bf16_t* KVT, LAS unsigned char* lds) {
    const int tid = threadIdx.x, lane = tid & 63, wv = __builtin_amdgcn_readfirstlane(tid >> 6);
    const int j = unit % NRC, h = (unit / NRC) & 7, b = unit / (NRC * 8);
    const int l15 = lane & 15, q = lane >> 4, trq = l15 >> 2, trp = lane & 3;
    const float lgf = -log1pf(expf(-gamma_logit[h])) * 1.4426950408889634f, lgb = -log1pf(expf(-gamma_logit[8 + h])) * 1.4426950408889634f;
    __syncthreads();
    retp_stage_k(P, b, h, j, lds);
#pragma unroll
    for (int i = 0; i < 4; ++i) { const int piece = tid + 512 * i, p = piece >> 4, ch = piece & 15;
        const u32x4 v = *(const u32x4*)(P + (size_t)retp_row(b, j * 128 + p) * LDP0 + 5120 + h * 128 + 8 * ch); const unsigned vw[4] = {v.x, v.y, v.z, v.w};
        const float sf = exp2f(lgf * (float)(127 - p)), sb = exp2f(lgb * (float)p);
        unsigned of[4], ob[4];
#pragma unroll
        for (int w = 0; w < 4; ++w) { of[w] = pk2(bflo(vw[w]) * sf, bfhi(vw[w]) * sf); ob[w] = pk2(bflo(vw[w]) * sb, bfhi(vw[w]) * sb); }
        *(LAS u32x4*)(lds + RP_V1 + p * R_RS + ch * 16) = (u32x4){of[0], of[1], of[2], of[3]}; *(LAS u32x4*)(lds + RP_V2 + p * R_RS + ch * 16) = (u32x4){ob[0], ob[1], ob[2], ob[3]}; }
    __syncthreads();
    f32x4 acc[2][8];
#pragma unroll
    for (int d = 0; d < 2; ++d)
#pragma unroll
        for (int c = 0; c < 8; ++c) acc[d][c] = (f32x4){0.f, 0.f, 0.f, 0.f};
#pragma unroll
    for (int kk = 0; kk < 4; ++kk) { const bf16x8 ktf = tr_frag(lds + RP_KS + (32 * kk + 8 * q + trq) * R_RS + (16 * wv + 4 * trp) * 2, 4 * R_RS);
#pragma unroll
        for (int c = 0; c < 8; ++c) { const bf16x8 v1 = tr_frag(lds + RP_V1 + (32 * kk + 8 * q + trq) * R_RS + (16 * c + 4 * trp) * 2, 4 * R_RS), v2 = tr_frag(lds + RP_V2 + (32 * kk + 8 * q + trq) * R_RS + (16 * c + 4 * trp) * 2, 4 * R_RS);
            acc[0][c] = __builtin_amdgcn_mfma_f32_16x16x32_bf16(ktf, v1, acc[0][c], 0, 0, 0); acc[1][c] = __builtin_amdgcn_mfma_f32_16x16x32_bf16(ktf, v2, acc[1][c], 0, 0, 0); } }
    const int nb = j < 2 ? 1 - j : 35 - j;
#pragma unroll
    for (int d = 0; d < 2; ++d) { bf16_t* dst = KVT + ((size_t)(((b * 8 + h) * 2 + d) * NRC + (d ? nb : j))) * 16384 + (size_t)l15 * 128 + 16 * wv + 4 * q;
#pragma unroll
        for (int c = 0; c < 8; ++c) { u32x2 w; w.x = pk2(acc[d][c][0], acc[d][c][1]); w.y = pk2(acc[d][c][2], acc[d][c][3]); *(u32x2*)(dst + (size_t)(16 * c) * 128) = w; } }
}
__device__ __forceinline__ void retp_scan_unit(int unit, const float* gamma_logit, const bf16_t* KVT, bf16_t* ST) {
    const int tid = threadIdx.x;
    const int bhd = unit >> 2, qtr = unit & 3, d = bhd & 1, h = (bhd >> 1) & 7;
    const float g128 = exp2f(-log1pf(expf(-gamma_logit[d * 8 + h])) * 1.4426950408889634f * 128.f);
    const u32x4* src = (const u32x4*)(KVT + (size_t)bhd * NRC * 16384) + qtr * 512 + tid; u32x4* dst = (u32x4*)(ST + (size_t)bhd * NRC * 16384) + qtr * 512 + tid;
    u32x4 kv[NRC];
#pragma unroll
    for (int n = 0; n < NRC; ++n) kv[n] = src[(size_t)n * 2048];
    float st[8];
#pragma unroll
    for (int k = 0; k < 8; ++k) st[k] = 0.f;
#pragma unroll
    for (int n = 0; n < NRC; ++n) {
        dst[(size_t)n * 2048] = (u32x4){pk2(st[0], st[1]), pk2(st[2], st[3]), pk2(st[4], st[5]), pk2(st[6], st[7])};
        const unsigned w[4] = {kv[n].x, kv[n].y, kv[n].z, kv[n].w};
#pragma unroll
        for (int k = 0; k < 4; ++k) { st[2 * k] = g128 * st[2 * k] + bflo(w[k]); st[2 * k + 1] = g128 * st[2 * k + 1] + bfhi(w[k]); }
    }
}
__device__ __forceinline__ void retp_out_unit(int unit, const bf16_t* P, const float* rotg, const float* gamma_logit, const bf16_t* ST, const float* gain, bf16_t* AO, LAS unsigned char* lds) {
    const int tid = threadIdx.x, lane = tid & 63, wv = __builtin_amdgcn_readfirstlane(tid >> 6);
    const int j = unit % NRC, h = (unit / NRC) & 7, b = unit / (NRC * 8);
    const int l15 = lane & 15, q = lane >> 4, trq = l15 >> 2, trp = lane & 3;
    const float lgf = -log1pf(expf(-gamma_logit[h])) * 1.4426950408889634f, lgb = -log1pf(expf(-gamma_logit[8 + h])) * 1.4426950408889634f;
    const float qscale = 0.08838834764831845f;
    __syncthreads();
    const int nbk = j < 2 ? 1 - j : 35 - j;
    const bf16_t* sF = ST + ((size_t)(((b * 8 + h) * 2 + 0) * NRC + j)) * 16384; const bf16_t* sB = ST + ((size_t)(((b * 8 + h) * 2 + 1) * NRC + nbk)) * 16384;
    u32x4 vr[4], sfr[4], sbr[4], gtr[4];
#pragma unroll
    for (int i = 0; i < 4; ++i) { const int piece = tid + 512 * i, p = piece >> 4, ch = piece & 15; const bf16_t* prow = P + (size_t)retp_row(b, j * 128 + p) * LDP0 + h * 128 + 8 * ch;
        vr[i] = *(const u32x4*)(prow + 5120); gtr[i] = *(const u32x4*)(prow + 1024); sfr[i] = *(const u32x4*)(sF + (size_t)piece * 8); sbr[i] = *(const u32x4*)(sB + (size_t)piece * 8); }
    __builtin_amdgcn_sched_barrier(0);
    retp_stage_k(P, b, h, j, lds);
#pragma unroll
    for (int i = 0; i < 4; ++i) { const int piece = tid + 512 * i, p = piece >> 4, ch = piece & 15;
        *(LAS u32x4*)(lds + RP_V1 + p * R_RS + ch * 16) = vr[i]; *(LAS u32x4*)(lds + RP_V2 + p * R_RS + ch * 16) = sfr[i]; }
    const int tl = 16 * wv + l15, sp = j * 128 + tl, row = retp_row(b, sp);
    bf16x8 qf[4];
    { const bf16_t* qp = P + (size_t)row * LDP0 + h * 128 + 8 * q;
        u32x4 raw[4];
#pragma unroll
        for (int kk = 0; kk < 4; ++kk) raw[kk] = *(const u32x4*)(qp + 32 * kk);
#pragma unroll
        for (int sec = 0; sec < 2; ++sec) { f32x4 c0 = (f32x4){1.f, 1.f, 1.f, 1.f}, c1 = c0, s0 = (f32x4){0.f, 0.f, 0.f, 0.f}, s1 = s0;
            if (sp >= CL) { const int t = sp - CL; const int pos = sec ? (t & 63) : (t >> 6);
                const LAS f32x4* cp = (const LAS f32x4*)(lds + RP_ROT + (pos * 32 + 8 * q) * 4); const LAS f32x4* spp = (const LAS f32x4*)(lds + RP_ROT + 8192 + (pos * 32 + 8 * q) * 4);
                c0 = cp[0]; c1 = cp[1]; s0 = spp[0]; s1 = spp[1]; }
            const float cc[8] = {c0[0], c0[1], c0[2], c0[3], c1[0], c1[1], c1[2], c1[3]}, ss[8] = {s0[0], s0[1], s0[2], s0[3], s1[0], s1[1], s1[2], s1[3]};
            const unsigned a1[4] = {raw[2 * sec].x, raw[2 * sec].y, raw[2 * sec].z, raw[2 * sec].w}, a2[4] = {raw[2 * sec + 1].x, raw[2 * sec + 1].y, raw[2 * sec + 1].z, raw[2 * sec + 1].w};
            unsigned o1[4], o2[4];
#pragma unroll
            for (int w = 0; w < 4; ++w) { const float qa0 = bflo(a1[w]) * qscale, qa1 = bfhi(a1[w]) * qscale, qb0 = bflo(a2[w]) * qscale, qb1 = bfhi(a2[w]) * qscale;
                const float ce = cc[2 * w], co = cc[2 * w + 1], se = ss[2 * w], so = ss[2 * w + 1];
                o1[w] = pk2(qa0 * ce - qb0 * se, qa1 * co - qb1 * so); o2[w] = pk2(qa0 * se + qb0 * ce, qa1 * so + qb1 * co); }
            qf[2 * sec] = __builtin_bit_cast(bf16x8, (u32x4){o1[0], o1[1], o1[2], o1[3]}); qf[2 * sec + 1] = __builtin_bit_cast(bf16x8, (u32x4){o2[0], o2[1], o2[2], o2[3]}); } }
    const float fa = exp2f(lgf * (float)l15), ba = exp2f(-lgb * (float)l15);
    float fbq[4], bbq[4];
#pragma unroll
    for (int r = 0; r < 4; ++r) { fbq[r] = exp2f(-lgf * (float)(4 * q + r)); bbq[r] = exp2f(lgb * (float)(4 * q + r)); }
    __syncthreads();
    f32x4 acc[8];
#pragma unroll
    for (int c = 0; c < 8; ++c) acc[c] = (f32x4){0.f, 0.f, 0.f, 0.f};
#pragma unroll
    for (int m = 0; m < 4; ++m) {
        unsigned pk[4];
#pragma unroll
        for (int hf = 0; hf < 2; ++hf) { const int st = 2 * m + hf;
            f32x4 X = (f32x4){0.f, 0.f, 0.f, 0.f};
#pragma unroll
            for (int kk = 0; kk < 4; ++kk) { const bf16x8 kf = *(const LAS bf16x8*)(lds + RP_KS + (16 * st + l15) * R_RS + (32 * kk + 8 * q) * 2); X = __builtin_amdgcn_mfma_f32_16x16x32_bf16(kf, qf[kk], X, 0, 0, 0); }
            float f[4];
            if (st < wv) { const float cf = exp2f(lgf * (float)(16 * (wv - st))) * fa;
#pragma unroll
                for (int r = 0; r < 4; ++r) f[r] = cf * fbq[r]; }
            else if (st > wv) { const float cb = exp2f(lgb * (float)(16 * (st - wv))) * ba;
#pragma unroll
                for (int r = 0; r < 4; ++r) f[r] = cb * bbq[r]; }
            else {
#pragma unroll
                for (int r = 0; r < 4; ++r) { const int sl = 4 * q + r; f[r] = sl < l15 ? fa * fbq[r] : (sl > l15 ? ba * bbq[r] : 2.f); } }
            pk[2 * hf] = pk2(X[0] * f[0], X[1] * f[1]); pk[2 * hf + 1] = pk2(X[2] * f[2], X[3] * f[3]); }
        const bf16x8 pa = __builtin_bit_cast(bf16x8, (u32x4){pk[0], pk[1], pk[2], pk[3]});
#pragma unroll
        for (int c = 0; c < 8; ++c) { const bf16x8 vf = tr_frag(lds + RP_V1 + (32 * m + 4 * q + trq) * R_RS + (16 * c + 4 * trp) * 2, 16 * R_RS);
            acc[c] = __builtin_amdgcn_mfma_f32_16x16x32_bf16(vf, pa, acc[c], 0, 0, 0); }
    }
#pragma unroll
    for (int d = 0; d < 2; ++d) {
        if (d == 1) { lds_barrier();
#pragma unroll
            for (int i = 0; i < 4; ++i) { const int piece = tid + 512 * i, p = piece >> 4, ch = piece & 15;
                *(LAS u32x4*)(lds + RP_KS + p * R_RS + ch * 16) = sbr[i]; *(LAS u32x4*)(lds + RP_V1 + p * R_RS + ch * 16) = gtr[i]; }
            lds_barrier(); }
        const LAS unsigned char* sb = lds + (d ? RP_KS : RP_V2) + l15 * R_RS + (8 * q) * 2;
        f32x4 t2[8];
#pragma unroll
        for (int c = 0; c < 8; ++c) t2[c] = (f32x4){0.f, 0.f, 0.f, 0.f};
#pragma unroll
        for (int kk = 0; kk < 4; ++kk)
#pragma unroll
            for (int c = 0; c < 8; ++c) { const bf16x8 sf = *(const LAS bf16x8*)(sb + (16 * c) * R_RS + 64 * kk); t2[c] = __builtin_amdgcn_mfma_f32_16x16x32_bf16(sf, qf[kk], t2[c], 0, 0, 0); }
        const float sc = d ? exp2f(lgb * (float)(128 - tl)) : exp2f(lgf * (float)(tl + 1));
#pragma unroll
        for (int c = 0; c < 8; ++c) acc[c] += t2[c] * sc;
    }
    float ss = 0.f;
#pragma unroll
    for (int c = 0; c < 8; ++c) ss += (acc[c][0] * acc[c][0] + acc[c][1] * acc[c][1]) + (acc[c][2] * acc[c][2] + acc[c][3] * acc[c][3]);
    ss += __shfl_xor(ss, 16); ss += __shfl_xor(ss, 32);
    const float rstd = rsqrtf(ss * (1.f / 128.f) + EPS);
    const LAS unsigned char* gp = lds + RP_V1 + tl * R_RS + (4 * q) * 2; bf16_t* op = AO + (size_t)row * D + h * 128 + 4 * q; const float* gn = gain + h * 128 + 4 * q;
#pragma unroll
    for (int c = 0; c < 8; ++c) { const u32x2 gw = *(const LAS u32x2*)(gp + 32 * c); const f32x4 g4 = *(const f32x4*)(gn + 16 * c);
        u32x2 o; o.x = pk2(acc[c][0] * rstd * g4[0] * silu_f(bflo(gw.x)), acc[c][1] * rstd * g4[1] * silu_f(bfhi(gw.x)));
        o.y = pk2(acc[c][2] * rstd * g4[2] * silu_f(bflo(gw.y)), acc[c][3] * rstd * g4[3] * silu_f(bfhi(gw.y)));
        *(u32x2*)(op + 16 * c) = o; }
}

constexpr int G_RS = 160, G_RSV = 288;
constexpr int G_QS = 0, G_KS = 64 * G_RS, G_KP = 2 * 64 * G_RS, G_VS = 3 * 64 * G_RS, G_ST = G_VS + 64 * G_RSV, G_SEG = G_ST + 128 * G_RS, G_BEND = G_SEG + 8 * 64 * 4, G_END = G_BEND + 256;
__device__ __forceinline__ int gla_lowrow(int b, int dir, int sp0) { return sp0 < CL ? M_LAT + b * CL + (dir ? CL - 64 - sp0 : sp0) : b * T + (dir ? T - 64 - (sp0 - CL) : sp0 - CL); }
__device__ __forceinline__ int gla_row(int b, int dir, int sp) { return sp < CL ? M_LAT + b * CL + (dir ? CL - 1 - sp : sp) : b * T + (dir ? T - 1 - (sp - CL) : sp - CL); }
__device__ __forceinline__ void gla_fast_unit(int unit, const bf16_t* P, const float* w_up, const float* b_up, float* Of, float* Ob, LAS unsigned char* lds0) {
    const int tid = threadIdx.x, lane = tid & 63, wv = __builtin_amdgcn_readfirstlane(tid >> 6);
    const int dir = unit & 1, h = (unit >> 1) & 7, b = unit >> 4;
    const int l15 = lane & 15, q = lane >> 4, trq = l15 >> 2, trp = lane & 3;
    float* O = dir ? Ob : Of;
    constexpr int NCH = (CL + T) / 64;
    static_assert(2 * G_END <= LDS_BARW, "GLA double buffer");
    __syncthreads();
    if (wv < 4) {
        const int mw = wv;
        const unsigned ooff = (unsigned)((dir ? 63 - l15 : l15) * 2048 + (h * 128 + 32 * mw + 4 * q) * 2);
        f32x4 S[4][2];
#pragma unroll
        for (int dt = 0; dt < 4; ++dt) { S[dt][0] = (f32x4){0.f, 0.f, 0.f, 0.f}; S[dt][1] = (f32x4){0.f, 0.f, 0.f, 0.f}; }
        for (int cidx = -1; cidx < NCH + 1; ++cidx) {
            LAS unsigned char* lds = lds0 + (cidx & 1) * G_END;
            lds_barrier();
            if (cidx >= CL / 64 && cidx < NCH) {
                bf16x8 sfr[2][2];
#pragma unroll
                for (int kk = 0; kk < 2; ++kk)
#pragma unroll
                    for (int et = 0; et < 2; ++et) { const u32x4 w = (u32x4){pk2(S[2 * kk][et][0], S[2 * kk][et][1]), pk2(S[2 * kk][et][2], S[2 * kk][et][3]), pk2(S[2 * kk + 1][et][0], S[2 * kk + 1][et][1]), pk2(S[2 * kk + 1][et][2], S[2 * kk + 1][et][3])};
                        sfr[kk][et] = __builtin_bit_cast(bf16x8, w); }
                bf16x8 kf[4][2];
#pragma unroll
                for (int st = 0; st < 4; ++st)
#pragma unroll
                    for (int kk = 0; kk < 2; ++kk) { const LAS unsigned char* kp = lds + G_KS + (16 * st + l15) * G_RS + (32 * kk + 4 * q) * 2;
                        const u32x2 a0 = *(const LAS u32x2*)kp, a1 = *(const LAS u32x2*)(kp + 32); kf[st][kk] = __builtin_bit_cast(bf16x8, (u32x4){a0.x, a0.y, a1.x, a1.y}); }
                bf16x8 vfo[2][2];
#pragma unroll
                for (int m = 0; m < 2; ++m)
#pragma unroll
                    for (int et = 0; et < 2; ++et) vfo[m][et] = tr_frag(lds + G_VS + (32 * m + 4 * q + trq) * G_RSV + (32 * mw + 16 * et + 4 * trp) * 2, 16 * G_RSV);
#pragma unroll
                for (int sg = 0; sg < 4; ++sg) {
                    bf16x8 qf[2];
#pragma unroll
                    for (int kk = 0; kk < 2; ++kk) { const LAS unsigned char* qp = lds + G_QS + (16 * sg + l15) * G_RS + (32 * kk + 4 * q) * 2;
                        const u32x2 a0 = *(const LAS u32x2*)qp, a1 = *(const LAS u32x2*)(qp + 32); qf[kk] = __builtin_bit_cast(bf16x8, (u32x4){a0.x, a0.y, a1.x, a1.y}); }
                    f32x4 accO[2] = {(f32x4){0.f, 0.f, 0.f, 0.f}, (f32x4){0.f, 0.f, 0.f, 0.f}};
#pragma unroll
                    for (int kk = 0; kk < 2; ++kk)
#pragma unroll
                        for (int et = 0; et < 2; ++et) accO[et] = __builtin_amdgcn_mfma_f32_16x16x32_bf16(sfr[kk][et], qf[kk], accO[et], 0, 0, 0);
#pragma unroll
                    for (int m = 0; m <= (sg >> 1); ++m) {
                        unsigned pk[4];
#pragma unroll
                        for (int hf = 0; hf < 2; ++hf) { const int st = 2 * m + hf;
                            if (st <= sg) { f32x4 X = (f32x4){0.f, 0.f, 0.f, 0.f};
#pragma unroll
                                for (int kk = 0; kk < 2; ++kk) X = __builtin_amdgcn_mfma_f32_16x16x32_bf16(kf[st][kk], qf[kk], X, 0, 0, 0);
                                if (st == sg) {
#pragma unroll
                                    for (int r = 0; r < 4; ++r) if (4 * q + r > l15) X[r] = 0.f; }
                                pk[2 * hf] = pk2(X[0], X[1]); pk[2 * hf + 1] = pk2(X[2], X[3]); }
                            else { pk[2 * hf] = 0u; pk[2 * hf + 1] = 0u; } }
                        const bf16x8 pa = __builtin_bit_cast(bf16x8, (u32x4){pk[0], pk[1], pk[2], pk[3]});
#pragma unroll
                        for (int et = 0; et < 2; ++et) accO[et] = __builtin_amdgcn_mfma_f32_16x16x32_bf16(vfo[m][et], pa, accO[et], 0, 0, 0);
                    }
                    { char* ob = (char*)O + (size_t)gla_lowrow(b, dir, cidx * 64) * 2048 + (ooff + (unsigned)((dir ? -sg : sg) * 16 * 2048));
#pragma unroll
                        for (int et = 0; et < 2; ++et) { u32x2 w; w.x = pk2(accO[et][0], accO[et][1]); w.y = pk2(accO[et][2], accO[et][3]); *(u32x2*)(ob + 32 * et) = w; } }
                }
            }
            lds_barrier();
            if (cidx >= 0 && cidx < NCH) {
#pragma unroll
                for (int dt = 0; dt < 4; ++dt) { const f32x4 dec = *(const LAS f32x4*)(lds + G_BEND + (16 * dt + 4 * q) * 4); S[dt][0] = S[dt][0] * dec; S[dt][1] = S[dt][1] * dec; }
#pragma unroll
                for (int kk = 0; kk < 2; ++kk) { bf16x8 vs[2];
#pragma unroll
                    for (int et = 0; et < 2; ++et) vs[et] = tr_frag(lds + G_VS + (32 * kk + 8 * q + trq) * G_RSV + (32 * mw + 16 * et + 4 * trp) * 2, 4 * G_RSV);
#pragma unroll
                    for (int dt = 0; dt < 4; ++dt) { const bf16x8 ktf = tr_frag(lds + G_KP + (32 * kk + 8 * q + trq) * G_RS + (16 * dt + 4 * trp) * 2, 4 * G_RS);
                        S[dt][0] = __builtin_amdgcn_mfma_f32_16x16x32_bf16(ktf, vs[0], S[dt][0], 0, 0, 0); S[dt][1] = __builtin_amdgcn_mfma_f32_16x16x32_bf16(ktf, vs[1], S[dt][1], 0, 0, 0); } }
            }
        }
    } else {
        const int pw = wv - 4, ptid = tid - 256;
        bf16x8 wfr[4]; float bu[4];
#pragma unroll
        for (int it = 0; it < 4; ++it) { unsigned w[4] = {0u, 0u, 0u, 0u};
            if (q < 2) {
#pragma unroll
                for (int j = 0; j < 4; ++j) w[j] = pk2(w_up[(size_t)(dir * 16 + 8 * q + 2 * j) * 512 + h * 64 + 16 * it + l15], w_up[(size_t)(dir * 16 + 8 * q + 2 * j + 1) * 512 + h * 64 + 16 * it + l15]); }
            wfr[it] = __builtin_bit_cast(bf16x8, (u32x4){w[0], w[1], w[2], w[3]}); bu[it] = b_up[dir * 512 + h * 64 + 16 * it + l15]; }
        u32x4 graw0; unsigned short qr0[4][4], kr0[4][4]; u32x4 vraw0[4];
        const unsigned goff = (unsigned)((dir ? 63 - (16 * pw + l15) : 16 * pw + l15) * (LDP1 * 2) + (6144 + dir * 16 + 8 * q) * 2);
        unsigned qkoff[4], voff[4];
#pragma unroll
        for (int r = 0; r < 4; ++r) { const int p = 16 * pw + 4 * q + r; qkoff[r] = (unsigned)((dir ? 63 - p : p) * (LDP1 * 2) + (h * 64 + l15) * 2); }
#pragma unroll
        for (int i = 0; i < 4; ++i) { const int piece = ptid + 256 * i, p = piece >> 4, ch = piece & 15; voff[i] = (unsigned)((dir ? 63 - p : p) * (LDP1 * 2) + (5120 + h * 128 + 8 * ch) * 2); }
#define GLA_LOAD(cc, graw, qr, kr, vraw) do { const char* cb = (const char*)P + (size_t)gla_lowrow(b, dir, (cc) * 64) * (LDP1 * 2); \
            graw = (u32x4){0u, 0u, 0u, 0u}; if (q < 2) graw = *(const u32x4*)(cb + goff); \
            _Pragma("unroll") for (int r = 0; r < 4; ++r) { \
                _Pragma("unroll") for (int it = 0; it < 4; ++it) { qr[it][r] = *(const unsigned short*)(cb + (qkoff[r] + (1024 + 16 * it) * 2)); kr[it][r] = *(const unsigned short*)(cb + (qkoff[r] + (4608 + 16 * it) * 2)); } } \
            _Pragma("unroll") for (int i = 0; i < 4; ++i) vraw[i] = *(const u32x4*)(cb + voff[i]); } while (0)
#define GLA_PREP(cidx_, graw, qr, kr, vraw, ngraw, nqr, nkr, nvraw) do { \
            const int cx = (cidx_); LAS unsigned char* ldn = lds0 + ((cx + 1) & 1) * G_END; const bool act = cx + 1 < NCH; \
            lds_barrier();                                                 \
            float la[4][4]; \
            if (act) { const bf16x8 ga = __builtin_bit_cast(bf16x8, graw); \
                _Pragma("unroll") for (int it = 0; it < 4; ++it) { f32x4 z = __builtin_amdgcn_mfma_f32_16x16x32_bf16(ga, wfr[it], (f32x4){bu[it], bu[it], bu[it], bu[it]}, 0, 0, 0); \
                    float c = 0.f; \
                    _Pragma("unroll") for (int r = 0; r < 4; ++r) { const float z2 = z[r] * 1.4426950408889634f; const float ls = (fminf(z2, 0.f) - __builtin_amdgcn_logf(1.f + __builtin_amdgcn_exp2f(-fabsf(z2)))) * 0.0625f; c += ls; la[it][r] = c; }     \
                    float inc = c; { const float t1 = __shfl_up(inc, 16); if (q >= 1) inc += t1; const float t2 = __shfl_up(inc, 32); if (q >= 2) inc += t2; } \
                    const float exq = inc - c; \
                    _Pragma("unroll") for (int r = 0; r < 4; ++r) la[it][r] += exq; \
                    if (q == 3) ((LAS float*)(ldn + G_SEG))[pw * 64 + 16 * it + l15] = inc; } } \
            lds_barrier();                                                 \
            if (act) { \
                _Pragma("unroll") for (int it = 0; it < 4; ++it) { float pre = 0.f, tot = 0.f; \
                    _Pragma("unroll") for (int w = 0; w < 4; ++w) { const float s = ((LAS float*)(ldn + G_SEG))[w * 64 + 16 * it + l15]; tot += s; pre += (w < pw) ? s : 0.f; } \
                    const float etot = __builtin_amdgcn_exp2f(tot); if (pw == 0 && q == 0) ((LAS float*)(ldn + G_BEND))[16 * it + l15] = etot; \
                    _Pragma("unroll") for (int r = 0; r < 4; ++r) { const int p = 16 * pw + 4 * q + r; const float bb = pre + la[it][r]; const float qv = bf2f(qr[it][r]) * 0.125f, kv = bf2f(kr[it][r]); \
                        const int off = p * G_RS + (16 * it + l15) * 2; \
                        const float kt = kv * __builtin_amdgcn_exp2f(-bb); \
                        *(LAS bf16_t*)(ldn + G_QS + off) = (bf16_t)f2bf(qv * __builtin_amdgcn_exp2f(bb)); \
                        *(LAS bf16_t*)(ldn + G_KS + off) = (bf16_t)f2bf(kt); \
                        *(LAS bf16_t*)(ldn + G_KP + off) = (bf16_t)f2bf(kt * etot); } } \
                _Pragma("unroll") for (int i = 0; i < 4; ++i) { const int piece = ptid + 256 * i, p = piece >> 4, ch = piece & 15; *(LAS u32x4*)(ldn + G_VS + p * G_RSV + ch * 16) = vraw[i]; } \
                if (cx + 2 < NCH) GLA_LOAD(cx + 2, ngraw, nqr, nkr, nvraw); } } while (0)
        GLA_LOAD(0, graw0, qr0, kr0, vraw0);
        for (int cidx = -1; cidx < NCH + 1; cidx += 2) {
            GLA_PREP(cidx, graw0, qr0, kr0, vraw0, graw0, qr0, kr0, vraw0);
            GLA_PREP(cidx + 1, graw0, qr0, kr0, vraw0, graw0, qr0, kr0, vraw0);
        }
#undef GLA_PREP
#undef GLA_LOAD
    }
    __syncthreads();
}

constexpr int GM_RS = 288;
constexpr int GM_VT = 0, GM_RSTD = 128 * GM_RS, GM_GN = 40960, GM_BS = 45056;
__device__ __forceinline__ float gelu_fast(float x) { const float y = 1.5957691216057308f * (x + 0.044715f * x * x * x); return x * __builtin_amdgcn_rcpf(1.f + __expf(-y)); }
__device__ __forceinline__ void gmlp_fast_unit(int ci, const bf16_t* P, const float* gnorm, const bf16_t* Wb, const float* bs_, bf16_t* AO, LAS unsigned char* lds) {
    const int tid = threadIdx.x, lane = tid & 63, wv = __builtin_amdgcn_readfirstlane(tid >> 6);
    const int row0 = ci < 128 ? (ci >> 5) * T + (ci & 31) * 128 : M_LAT + ((ci - 128) >> 1) * CL + ((ci - 128) & 1) * 128;
    const int l15 = lane & 15, q = lane >> 4, trq = l15 >> 2, trp = lane & 3;
    LAS float* rs = (LAS float*)(lds + GM_RSTD);
    LAS float* gnl = (LAS float*)(lds + GM_GN); LAS float* bsl = (LAS float*)(lds + GM_BS);
    __syncthreads();
    *(LAS f32x2*)(gnl + 2 * tid) = *(const f32x2*)(gnorm + 2 * tid); *(LAS f32x2*)(bsl + 2 * tid) = *(const f32x2*)(bs_ + 2 * tid);
    { const int row = tid >> 2, qq = tid & 3; const u32x4* vp = (const u32x4*)(P + (size_t)(row0 + row) * LDP0 + 3072 + qq * 256); float ss = 0.f;
#pragma unroll 4
        for (int i = 0; i < 32; ++i) { const u32x4 w = vp[i]; const unsigned ww[4] = {w.x, w.y, w.z, w.w};
#pragma unroll
            for (int c = 0; c < 4; ++c) { const float a0 = gelu_fast(bflo(ww[c])), a1 = gelu_fast(bfhi(ww[c])); ss += a0 * a0 + a1 * a1; } }
        ss += __shfl_xor(ss, 1); ss += __shfl_xor(ss, 2);
        if (qq == 0) rs[row] = rsqrtf(ss * (1.f / 1024.f) + EPS); }
    __syncthreads();
    const int p = 16 * wv + l15;
    for (int g = 0; g < 8; ++g) {
#pragma unroll
        for (int i = 0; i < 4; ++i) { const int id = tid + 512 * i, s = id >> 4, ch = id & 15;
            const u32x4 w = *(const u32x4*)(P + (size_t)(row0 + s) * LDP0 + 3072 + g * 128 + 8 * ch); const unsigned ww[4] = {w.x, w.y, w.z, w.w};
            const float rr = rs[s]; const f32x4 g0 = *(const LAS f32x4*)(gnl + g * 128 + 8 * ch), g1 = *(const LAS f32x4*)(gnl + g * 128 + 8 * ch + 4);
            const float gg[8] = {g0[0], g0[1], g0[2], g0[3], g1[0], g1[1], g1[2], g1[3]};
            unsigned ow[4];
#pragma unroll
            for (int c = 0; c < 4; ++c) ow[c] = pk2(gelu_fast(bflo(ww[c])) * rr * gg[2 * c], gelu_fast(bfhi(ww[c])) * rr * gg[2 * c + 1]);
            *(LAS u32x4*)(lds + GM_VT + s * GM_RS + ch * 16) = (u32x4){ow[0], ow[1], ow[2], ow[3]}; }
        bf16x8 wf[4];
        { const bf16_t* wp = Wb + (size_t)g * 16384 + (size_t)p * 128 + 8 * q;
#pragma unroll
            for (int kk = 0; kk < 4; ++kk) wf[kk] = *(const bf16x8*)(wp + 32 * kk); }
        lds_barrier();
        f32x4 acc[8];
#pragma unroll
        for (int ct = 0; ct < 8; ++ct) acc[ct] = (f32x4){0.f, 0.f, 0.f, 0.f};
#pragma unroll
        for (int kk = 0; kk < 4; ++kk)
#pragma unroll
            for (int ct = 0; ct < 8; ++ct) { const bf16x8 vf = tr_frag(lds + GM_VT + (32 * kk + 8 * q + trq) * GM_RS + (16 * ct + 4 * trp) * 2, 4 * GM_RS);
                acc[ct] = __builtin_amdgcn_mfma_f32_16x16x32_bf16(vf, wf[kk], acc[ct], 0, 0, 0); }
        lds_barrier();
        const float bias = bsl[g * 128 + p];
        const bf16_t* up = P + (size_t)(row0 + p) * LDP0 + 2048 + g * 128 + 4 * q; bf16_t* op = AO + (size_t)(row0 + p) * D + 1024 + g * 128 + 4 * q;
#pragma unroll
        for (int ct = 0; ct < 8; ++ct) { const u32x2 uw = *(const u32x2*)(up + 16 * ct);
            u32x2 o; o.x = pk2(gelu_fast(bflo(uw.x)) * (acc[ct][0] + bias), gelu_fast(bfhi(uw.x)) * (acc[ct][1] + bias));
            o.y = pk2(gelu_fast(bflo(uw.y)) * (acc[ct][2] + bias), gelu_fast(bfhi(uw.y)) * (acc[ct][3] + bias));
            *(u32x2*)(op + 16 * ct) = o; }
    }
}

constexpr int NA_RSK = 272, NA_RSV = 288;
constexpr int NA_KB = 0, NA_VB = 128 * NA_RSK, NA_BUF = 128 * NA_RSK + 128 * NA_RSV;
constexpr int NA_O1 = 0, NA_ML = 4 * 8192;
static_assert(2 * NA_BUF <= LDS_BARW && NA_ML + 1024 <= 2 * NA_BUF, "NA LDS map");
__device__ __forceinline__ void na_fast_unit(int unit, const bf16_t* P, const float* rpb, bf16_t* AO, LAS unsigned char* lds) {
    const int tid = threadIdx.x, lane = tid & 63, wv = __builtin_amdgcn_readfirstlane(tid >> 6);
    const int cq = wv & 3, kh = wv >> 2;
    const int r = unit & 63, h = (unit >> 6) & 7, b = unit >> 9;
    const int l15 = lane & 15, q = lane >> 4, trq = l15 >> 2, trp = lane & 3;
    const int rstart = min(max(r - 4, 0), 56);
    const int col = 16 * cq + l15, cstart = min(max(col - 8, 0), 48);
    const int ct0 = min(max(cq - 1, 0), 1);
    const float scale = 0.08838834764831845f;
    bf16x8 qf[4];
    { const bf16_t* qp = P + (size_t)(b * T + r * 64 + col) * LDP1 + h * 128 + 8 * q;
#pragma unroll
        for (int kk = 0; kk < 4; ++kk) qf[kk] = *(const bf16x8*)(qp + 32 * kk); }
    u32x4 rk[4], rv[4];
#define NA_LOAD(s) do { _Pragma("unroll") for (int i_ = 0; i_ < 4; ++i_) { const int id = tid + 512 * i_, key = id >> 4, ch = id & 15; \
        const int row = (s) < 4 ? b * T + (rstart + 2 * (s) + (key >> 6)) * 64 + (key & 63) : M_LAT + b * CL + 128 * ((s) - 4) + key; \
        const bf16_t* pr = P + (size_t)row * LDP1 + 2560 + h * 128 + 8 * ch; rk[i_] = *(const u32x4*)pr; rv[i_] = *(const u32x4*)(pr + 1024); } } while (0)
#define NA_STORE(bufp) do { _Pragma("unroll") for (int i_ = 0; i_ < 4; ++i_) { const int id = tid + 512 * i_, key = id >> 4, ch = id & 15; \
        *(LAS u32x4*)((bufp) + NA_KB + key * NA_RSK + ch * 16) = rk[i_]; *(LAS u32x4*)((bufp) + NA_VB + key * NA_RSV + ch * 16) = rv[i_]; } } while (0)
    float m = -1.0e30f, l = 0.f;
    f32x4 accO[8];
#pragma unroll
    for (int c = 0; c < 8; ++c) accO[c] = (f32x4){0.f, 0.f, 0.f, 0.f};
    __syncthreads();
    NA_LOAD(0); NA_STORE(lds);
    __syncthreads();
    for (int s = 0; s < 6; ++s) {
        LAS unsigned char* buf = lds + (s & 1) * NA_BUF;
        if (s + 1 < 6) NA_LOAD(s + 1);
        const bool win = s < 4;
        f32x4 sc[4];
        const int kr = rstart + 2 * s + kh;
        const float* bp = rpb + (h * 15 + (win ? kr - r + 7 : 0)) * 31 - col + 15;
#pragma unroll
        for (int j = 0; j < 4; ++j) {
            if (win && j == 3) { sc[j] = (f32x4){-1.0e30f, -1.0e30f, -1.0e30f, -1.0e30f}; }
            else { const int lk = 64 * kh + (win ? 16 * (ct0 + j) : 16 * j) + l15;
                f32x4 X = (f32x4){0.f, 0.f, 0.f, 0.f};
#pragma unroll
                for (int kk = 0; kk < 4; ++kk) { const bf16x8 kf = *(const LAS bf16x8*)(buf + NA_KB + lk * NA_RSK + (32 * kk + 8 * q) * 2); X = __builtin_amdgcn_mfma_f32_16x16x32_bf16(kf, qf[kk], X, 0, 0, 0); }
                if (win) {
#pragma unroll
                    for (int rg = 0; rg < 4; ++rg) { const int kc = 16 * (ct0 + j) + 4 * q + rg; const bool ok = kc >= cstart && kc < cstart + 16;
                        float bias = 0.f; if (ok) bias = bp[kc];
                        sc[j][rg] = ok ? X[rg] * scale + bias : -1.0e30f; }
                } else sc[j] = X * scale; } }
        float ms = fmaxf(fmaxf(fmaxf(sc[0][0], sc[0][1]), fmaxf(sc[0][2], sc[0][3])), fmaxf(fmaxf(sc[1][0], sc[1][1]), fmaxf(sc[1][2], sc[1][3])));
        ms = fmaxf(ms, fmaxf(fmaxf(fmaxf(sc[2][0], sc[2][1]), fmaxf(sc[2][2], sc[2][3])), fmaxf(fmaxf(sc[3][0], sc[3][1]), fmaxf(sc[3][2], sc[3][3]))));
        ms = fmaxf(ms, __shfl_xor(ms, 16)); ms = fmaxf(ms, __shfl_xor(ms, 32));
        const float mn = fmaxf(m, ms), alpha = __expf(m - mn);
        m = mn;
        float ps = 0.f;
#pragma unroll
        for (int j = 0; j < 4; ++j)
#pragma unroll
            for (int rg = 0; rg < 4; ++rg) { const float p = __expf(sc[j][rg] - mn); sc[j][rg] = p; ps += p; }
        l = l * alpha + ps;
        float az[4];
#pragma unroll
        for (int rg = 0; rg < 4; ++rg) az[rg] = __shfl(alpha, 4 * q + rg);
#pragma unroll
        for (int c = 0; c < 8; ++c)
#pragma unroll
            for (int rg = 0; rg < 4; ++rg) accO[c][rg] *= az[rg];
#pragma unroll
        for (int pi = 0; pi < 2; ++pi) {
            const u32x4 pw = (u32x4){pk2(sc[2 * pi][0], sc[2 * pi][1]), pk2(sc[2 * pi][2], sc[2 * pi][3]), pk2(sc[2 * pi + 1][0], sc[2 * pi + 1][1]), pk2(sc[2 * pi + 1][2], sc[2 * pi + 1][3])};
            const bf16x8 pa = __builtin_bit_cast(bf16x8, pw);
            const int lk0 = 64 * kh + (win ? 16 * (ct0 + 2 * pi) : 32 * pi) + 4 * q + trq;
            const int hoff = (win && pi == 1) ? 0 : 16 * NA_RSV;
#pragma unroll
            for (int c = 0; c < 8; ++c) { const bf16x8 vf = tr_frag(buf + NA_VB + lk0 * NA_RSV + (16 * c + 4 * trp) * 2, hoff);
                accO[c] = __builtin_amdgcn_mfma_f32_16x16x32_bf16(pa, vf, accO[c], 0, 0, 0); }
        }
        if (s + 1 < 6) NA_STORE(lds + ((s + 1) & 1) * NA_BUF);
        lds_barrier();
    }
#undef NA_LOAD
#undef NA_STORE
    l += __shfl_xor(l, 16); l += __shfl_xor(l, 32);
    LAS float* ml = (LAS float*)(lds + NA_ML) + (cq * 2 + kh) * 32;
    if (q == 0) { ml[l15] = m; ml[16 + l15] = l; }
    if (kh == 1) { LAS float* o1 = (LAS float*)(lds + NA_O1 + cq * 8192);
#pragma unroll
        for (int c = 0; c < 8; ++c)
#pragma unroll
            for (int rg = 0; rg < 4; ++rg) o1[(4 * q + rg) * 128 + 16 * c + l15] = accO[c][rg]; }
    __syncthreads();
    if (kh == 0) {
        const LAS float* ml0 = (const LAS float*)(lds + NA_ML) + (cq * 2) * 32; const LAS float* ml1 = ml0 + 32;
        const LAS float* o1 = (const LAS float*)(lds + NA_O1 + cq * 8192);
        float f0[4], f1[4];
#pragma unroll
        for (int rg = 0; rg < 4; ++rg) { const int t = 4 * q + rg; const float m0 = ml0[t], m1 = ml1[t], mm = fmaxf(m0, m1);
            const float e0 = __expf(m0 - mm), e1 = __expf(m1 - mm); const float inv = 1.f / (ml0[16 + t] * e0 + ml1[16 + t] * e1);
            f0[rg] = e0 * inv; f1[rg] = e1 * inv; }
#pragma unroll
        for (int rg = 0; rg < 4; ++rg) { bf16_t* op = AO + (size_t)(b * T + r * 64 + 16 * cq + 4 * q + rg) * D + h * 128 + l15;
#pragma unroll
            for (int c = 0; c < 8; ++c) op[16 * c] = (bf16_t)f2bf(accO[c][rg] * f0[rg] + o1[(4 * q + rg) * 128 + 16 * c + l15] * f1[rg]); }
    }
    __syncthreads();
}

__global__ void __launch_bounds__(512, 2) mk_fwd(Args a) {
    extern __shared__ __attribute__((aligned(16))) unsigned char lds_raw[];
    LAS unsigned char* lds = (LAS unsigned char*)lds_raw;
    const int tid = threadIdx.x;
    if (tid < 16) ((LAS unsigned*)(lds + LDS_BARW))[tid] = 0u;
    __syncthreads();
    const int lo = a.lo, hi = a.hi;
    XcdBarrier bar; bar.bar = (unsigned*)(a.ws + WS_CTL) + 4096; bar.x = 0; bar.st = (volatile LAS unsigned*)(lds + LDS_BARW);
    if (hi - lo > 1) bar = xcd_barrier_post((unsigned*)(a.ws + WS_CTL) + 4096, (volatile LAS unsigned*)(lds + LDS_BARW));
#ifdef ONLY_PHASE
#define IN(k) ((k) == ONLY_PHASE && lo <= (k) && (k) < hi)
#else
#define IN(k) (lo <= (k) && (k) < hi)
#endif
#define SEAM(k) do { if (IN(k) && IN((k) + 1)) xcd_barrier(bar); } while (0)
#ifndef DUPMASK
#define DUPMASK 0u
#endif
#define REPS(k) for (int rep = 0; rep < 1 + (int)((DUPMASK >> (k)) & 1u); ++rep)
#define REPBAR() do { if (rep) xcd_barrier(bar); } while (0)
    unsigned char* ws = a.ws;
    float* MOD = (float*)(ws + WS_MOD);
    const float* rotc = (const float*)(ws + WS_ROT); const float* rots = rotc + 2048;
    float* AFF = (float*)(ws + WS_AFF); int* SRC = (int*)(ws + WS_SRC); float* GATE = (float*)(ws + WS_GATE); int* INV = (int*)(ws + WS_INV);
    bf16_t* Win0 = (bf16_t*)(ws + WS_WIN0); bf16_t* Wout0 = (bf16_t*)(ws + WS_WOUT0); bf16_t* Win1 = (bf16_t*)(ws + WS_WIN1); bf16_t* Wout1 = (bf16_t*)(ws + WS_WOUT1);
    bf16_t* Wgu = (bf16_t*)(ws + WS_WGU); bf16_t* Wdn = (bf16_t*)(ws + WS_WDN);
    bf16_t* X1 = (bf16_t*)(ws + WS_X1); bf16_t* Hb = (bf16_t*)(ws + WS_HB); bf16_t* Pb = (bf16_t*)(ws + WS_P); bf16_t* AO = (bf16_t*)(ws + WS_AO);
    float* Of = (float*)(ws + WS_OF); float* Ob = (float*)(ws + WS_OB);
    bf16_t* Xg = (bf16_t*)(ws + WS_XG); bf16_t* Hm = (bf16_t*)(ws + WS_HM); bf16_t* Ye = (bf16_t*)(ws + WS_YE);
    const int G = gridDim.x, bid = blockIdx.x;

    if (IN(0)) REPS(0) { REPBAR(); phase_prologue(a, lds); }
    SEAM(0);
    if (IN(1)) REPS(1) { REPBAR(); phase_modnorm(a.in[I_X], a.in[I_CTX], M_ALL, a.in[I_NMIX], MOD, 0, D, Hb); }
    SEAM(1);
    if (IN(2)) REPS(2) { REPBAR();  pg8::Gemm g{Hb, Win0, D}; pg8::StaticOrder S; S.init(M_ALL, LDP0, G, bid, M_LAT); pg8::EpiStore E{Pb, LDP0}; pg8::gemm_phase(lds, g, S, E); }
    SEAM(2);
    if (IN(3)) {
        for (int i = tid; i < 4096; i += 512) ((LAS float*)(lds + RP_ROT))[i] = rotc[i];
        unsigned* qctr3 = (unsigned*)(ws + WS_CTL) + 8192 + 256;
        for (;;) {
            __syncthreads();
            if (tid == 0) *(volatile LAS unsigned*)(lds + LDS_BARW + 32) = atomicAdd(qctr3, 1u);
            __syncthreads();
            const unsigned u = *(volatile LAS unsigned*)(lds + LDS_BARW + 32);
            if (u >= 136u + (unsigned)(NB * 8 * NRC)) break;
            if (u < 136u) gmlp_fast_unit((int)u, Pb, a.in[I_GMLPN], (const bf16_t*)(ws + WS_GMW), a.in[I_GMLPB], AO, lds);
            else retp_kv_unit((int)u - 136, Pb, rotc, a.in[I_GAMMA], (bf16_t*)(ws + WS_OF), lds);
        }
    }
    if (IN(3) && IN(4)) xcd_barrier(bar);
    if (IN(4)) { for (int u = bid; u < NB * 8 * 2 * 4; u += G) retp_scan_unit(u, a.in[I_GAMMA], (const bf16_t*)(ws + WS_OF), (bf16_t*)(ws + WS_OB)); }
    if (IN(4) && IN(8)) xcd_barrier(bar);
    if (IN(8)) {
        for (int i = tid; i < 4096; i += 512) ((LAS float*)(lds + RP_ROT))[i] = rotc[i];
        for (int u = bid; u < NB * 8 * NRC; u += G) retp_out_unit(u, Pb, rotc, a.in[I_GAMMA], (const bf16_t*)(ws + WS_OB), a.in[I_RETN], AO, lds);
    }
    if (IN(8) && IN(5)) xcd_barrier(bar);
    if (IN(5)) REPS(5) { REPBAR();  pg8::Gemm g{AO, Wout0, D}; pg8::StaticOrder S; S.init(M_ALL, D, G, bid, M_LAT); pg8::EpiResid<false> E{a.in[I_X], a.in[I_CTX], X1, MOD + 2 * D}; pg8::gemm_phase(lds, g, S, E); }
    SEAM(5);
    if (IN(6)) REPS(6) { REPBAR(); phase_modnorm_router(X1, M_ALL, a.in[I_NFFN], MOD, 3 * D, 4 * D, Hb, a.in[I_ROUTER], AFF, lds); }
    SEAM(6);
    if (IN(7)) REPS(7) { REPBAR(); phase_topk(AFF, SRC, GATE, INV, RPE0, true, lds); }
    if (IN(7) && IN(9)) xcd_barrier(bar);
    if (IN(9)) REPS(9) { REPBAR();  pg8::Gemm g{Hb, Wgu, D}; pg8::MoeOrder S; S.init(RPE0 / 256, 16, G, bid, 8); pg8::EpiSiluMul E{Hm}; pg8::gemm_phase<pg8::EpiSiluMul, pg8::MoeOrder, true>(lds, g, S, E, SRC); }
    SEAM(9);
    if (IN(10)) REPS(10) { REPBAR();  pg8::Gemm g{Hm, nullptr, D}; pg8::BSrcF32 bs{a.in[I_WDOWN], a.in[I_WDOWN], 8, 256, 128}; pg8::MoeOrder S; S.init(RPE0 / 256, 8, G, bid, 8); pg8::EpiStore E{Ye, D}; pg8::gemm_phase_fb<pg8::EpiStore, pg8::MoeOrder, false, true>(lds, g, bs, S, E); }
    SEAM(10);
    if (IN(11)) REPS(11) { REPBAR(); phase_moe_combine<false>(X1, Ye, INV, GATE, MOD + 5 * D, M_ALL, a.in[I_NMIX] + D, MOD + 5 * 12288, Hb, nullptr); }
    SEAM(11);
    if (IN(12)) REPS(12) { REPBAR();  pg8::Gemm g{Hb, Win1, D}; pg8::StaticOrderTailCols<10> S; S.init(M_ALL, LDP1, G, bid, M_LAT); pg8::EpiStore E{Pb, LDP1}; pg8::gemm_phase(lds, g, S, E); }
    SEAM(12);
    if (IN(13)) REPS(13) {
        REPBAR();
        if (bid < 64) { gla_fast_unit(bid, Pb, a.in[I_GLAWUP], a.in[I_GLABUP], Of, Ob, lds); }
        unsigned* qctr = (unsigned*)(ws + WS_CTL) + 8192 + 64 * rep;
        for (;;) {
            __syncthreads();
            if (tid == 0) *(volatile LAS unsigned*)(lds + LDS_BARW + 32) = atomicAdd(qctr, 1u);
            __syncthreads();
            const unsigned u = *(volatile LAS unsigned*)(lds + LDS_BARW + 32);
            if (u >= (unsigned)(NB * 8 * 64)) break;
            na_fast_unit((int)u, Pb, a.in[I_RPB], AO, lds);
        }
    }
    SEAM(13);
    if (IN(14)) REPS(14) { REPBAR(); phase_head_combine_bf16((const bf16_t*)Of, (const bf16_t*)Ob, Pb, LDP1, 1536, a.in[I_GLAN], AO, 1024, M_LAT); }
    SEAM(14);
    if (IN(15)) REPS(15) { REPBAR();  pg8::Gemm g{AO, Wout1, D}; pg8::StaticOrder S; S.init(M_LAT, D, G, bid); pg8::EpiResid<true> E{nullptr, nullptr, X1, MOD + 5 * 12288 + 2 * D}; pg8::gemm_phase(lds, g, S, E); }
    SEAM(15);
    if (IN(16)) REPS(16) { REPBAR(); phase_modnorm_router(X1, M_LAT, a.in[I_NFFN] + D, MOD + 5 * 12288, 3 * D, 4 * D, Hb, a.in[I_ROUTER] + (size_t)D * NE, AFF, lds); }
    SEAM(16);
    if (IN(17)) REPS(17) { REPBAR(); phase_topk(AFF, SRC, GATE, INV, RPE1, false, lds); }
    if (IN(17) && IN(19)) xcd_barrier(bar);
    if (IN(19)) REPS(19) { REPBAR();  pg8::Gemm g{Hb, Wgu + (size_t)NE * 4096 * 2048, D}; pg8::MoeOrder S; S.init(RPE1 / 256, 16, G, bid); pg8::EpiSiluMul E{Hm}; pg8::gemm_phase<pg8::EpiSiluMul, pg8::MoeOrder, true>(lds, g, S, E, SRC); }
    SEAM(19);
    if (IN(20)) REPS(20) { REPBAR();  pg8::Gemm g{Hm, nullptr, D}; pg8::BSrcF32 bs{a.in[I_WDOWN] + (size_t)NE * 2048 * 2048, a.in[I_WDOWN] + (size_t)NE * 2048 * 2048, 8, 256, 128}; pg8::MoeOrder S; S.init(RPE1 / 256, 8, G, bid); pg8::EpiStore E{Ye, D}; pg8::gemm_phase_fb<pg8::EpiStore, pg8::MoeOrder, false>(lds, g, bs, S, E); }
    SEAM(20);
    if (IN(21)) REPS(21) { REPBAR(); phase_moe_combine<true>(X1, Ye, INV, GATE, MOD + 5 * 12288 + 5 * D, M_LAT, a.in[I_NFIN], nullptr, nullptr, a.out); }
#undef IN
#undef SEAM
}

extern "C" void kernel_launch(void* const* d_in, const int* in_sizes, int n_in, void* d_out, int out_size, void* d_ws, size_t ws_size, hipStream_t stream) {
    static int grid = 0;
    if (grid == 0) {
        if (n_in != 26 || out_size != M_LAT * D || ws_size < WS_END) { fprintf(stderr, "kernel_launch: unexpected problem (n_in %d, out %d, ws %zu < %zu)\n", n_in, out_size, ws_size, (size_t)WS_END); grid = -1; return; }
        int dev = 0, cus = 0, per_cu = 0;
        if (hipGetDevice(&dev) != hipSuccess || hipDeviceGetAttribute(&cus, hipDeviceAttributeMultiprocessorCount, dev) != hipSuccess) { grid = -1; return; }
        if (hipFuncSetAttribute((const void*)mk_fwd, hipFuncAttributeMaxDynamicSharedMemorySize, LDS_BYTES) != hipSuccess) { fprintf(stderr, "kernel_launch: hipFuncSetAttribute failed\n"); grid = -1; return; }
        if (hipOccupancyMaxActiveBlocksPerMultiprocessor(&per_cu, (const void*)mk_fwd, 512, LDS_BYTES) != hipSuccess || per_cu < 1) fprintf(stderr, "kernel_launch: occupancy query says %d\n", per_cu);
        (void)hipGetLastError();
        grid = cus;
    }
    if (grid < 0) return;
    (void)hipMemsetAsync((char*)d_ws + WS_CTL, 0, CTL_BYTES, stream);
    Args a{};
    for (int i = 0; i < 26; ++i) a.in[i] = (const float*)d_in[i];
    a.out = (float*)d_out; a.ws = (unsigned char*)d_ws;
#if MK_SPLIT
    { const int order[20] = {0, 1, 2, 3, 4, 8, 5, 6, 7, 9, 10, 11, 12, 13, 14, 15, 16, 17, 19, 20};
        for (int i = 0; i < 20; ++i) { a.lo = order[i]; a.hi = order[i] + 1; hipLaunchKernelGGL(mk_fwd, dim3(grid), dim3(512), LDS_BYTES, stream, a); }
        a.lo = 21; a.hi = 22; hipLaunchKernelGGL(mk_fwd, dim3(grid), dim3(512), LDS_BYTES, stream, a); }
#else
    a.lo = 0; a.hi = NPH; hipLaunchKernelGGL(mk_fwd, dim3(grid), dim3(512), LDS_BYTES, stream, a);
#endif
}
```

```cpp
#include <hip/hip_runtime.h>
#include <cstdio>
#include <cstdint>

#ifndef MK_SPLIT
#define MK_SPLIT 0
#endif

#define LAS __attribute__((address_space(3)))
typedef unsigned short bf16_t;
typedef short bf16x8 __attribute__((ext_vector_type(8)));
typedef float f32x4 __attribute__((ext_vector_type(4)));
typedef float f32x2 __attribute__((ext_vector_type(2)));
typedef unsigned u32x4 __attribute__((ext_vector_type(4)));
typedef unsigned u32x2 __attribute__((ext_vector_type(2)));
typedef short s16x4 __attribute__((ext_vector_type(4)));

constexpr int D = 2048, NB = 4, T = 4096, CL = 256, NE = 16;
constexpr int M_LAT = NB * T, M_CTX = NB * CL, M_ALL = M_LAT + M_CTX;
constexpr float EPS = 1e-6f;
constexpr int LDP0 = 6144, LDP1 = 6400;
constexpr int RPE0 = 2304, RPE1 = 2048;
constexpr int NPH = 22;

constexpr size_t MiB = 1u << 20;
constexpr size_t WS_CTL = 0, CTL_BYTES = 1 * MiB;
constexpr size_t WS_MOD = 1 * MiB;
constexpr size_t WS_ROT = 2 * MiB;
constexpr size_t WS_GMW = 2 * MiB + 512 * 1024;
constexpr size_t WS_AFF = 3 * MiB;
constexpr size_t WS_SRC = 5 * MiB;
constexpr size_t WS_GATE = 6 * MiB;
constexpr size_t WS_INV = 7 * MiB;
constexpr size_t WS_WIN0 = 16 * MiB, WS_WOUT0 = 40 * MiB, WS_WIN1 = 48 * MiB, WS_WOUT1 = 74 * MiB;
constexpr size_t WS_WGU = 82 * MiB;
constexpr size_t WS_WDN = 594 * MiB;
constexpr size_t WS_X1 = 850 * MiB;
constexpr size_t WS_HB = 986 * MiB;
constexpr size_t WS_P = 1054 * MiB;
constexpr size_t WS_AO = 1267 * MiB;
constexpr size_t WS_OF = 1335 * MiB, WS_OB = 1403 * MiB;
constexpr size_t WS_XG = 1471 * MiB, WS_HM = 1615 * MiB, WS_YE = 1759 * MiB;
constexpr size_t WS_END = 1903 * MiB;

constexpr int LDS_BYTES = 147456;
constexpr int LDS_BARW = LDS_BYTES - 64;

__device__ __forceinline__ float bf2f(unsigned v) { return __uint_as_float(v << 16); }
__device__ __forceinline__ float bflo(unsigned w) { return __uint_as_float(w << 16); }
__device__ __forceinline__ float bfhi(unsigned w) { return __uint_as_float(w & 0xffff0000u); }
typedef __bf16 bf2_t __attribute__((ext_vector_type(2)));
__device__ __forceinline__ unsigned f2bf(float f) { return (unsigned)__builtin_bit_cast(unsigned short, (__bf16)f); }
__device__ __forceinline__ unsigned pk2(float lo, float hi) { bf2_t v; v[0] = (__bf16)lo; v[1] = (__bf16)hi; return __builtin_bit_cast(unsigned, v); }
__device__ __forceinline__ float silu_f(float x) { return x / (1.f + __expf(-x)); }
__device__ __forceinline__ float gelu_tanh_f(float x) { const float y = 0.7978845608028654f * (x + 0.044715f * x * x * x); return x / (1.f + __expf(-2.f * y)); }
__device__ __forceinline__ float wave_sum(float v) {
#pragma unroll
    for (int o = 1; o < 64; o <<= 1) v += __shfl_xor(v, o);
    return v;
}
__device__ __forceinline__ float wave_max(float v) {
#pragma unroll
    for (int o = 1; o < 64; o <<= 1) v = fmaxf(v, __shfl_xor(v, o));
    return v;
}

__device__ __forceinline__ void lds_barrier() { asm volatile("s_waitcnt lgkmcnt(0)" ::: "memory"); __builtin_amdgcn_s_barrier(); asm volatile("" ::: "memory"); }
#define XB_TMO      128
#define XB_XCNT(j)  (256  + 64 * (j))
#define XB_XSUB(j)  (1280 + 64 * (j))
#define XB_XGEN(j)  (2304 + 64 * (j))
#define XB_TOP      3328
#define XB_TOPGEN   3392
#define XCD_BAR_WORDS 3456
#define XB_SPIN_CAP (1u << 18)
__device__ __forceinline__ unsigned xb_ld(unsigned* p)              { return __hip_atomic_load(p, __ATOMIC_RELAXED, __HIP_MEMORY_SCOPE_AGENT); }
__device__ __forceinline__ unsigned xb_add(unsigned* p, unsigned v) { return __hip_atomic_fetch_add(p, v, __ATOMIC_RELAXED, __HIP_MEMORY_SCOPE_AGENT); }
__device__ __forceinline__ unsigned xb_xcc_id() { return (unsigned)__builtin_amdgcn_s_getreg((3 << 11) | 20) & 0xFu; }
#define XB_SPIN(cond, bar) do { unsigned _sp = 0; while (cond) { __builtin_amdgcn_s_sleep(1); \
    if ((++_sp & 255u) == 0u) { if (xb_ld(&(bar)[XB_TMO])) break; if (_sp > XB_SPIN_CAP) { atomicAdd(&(bar)[XB_TMO], 1u); break; } } } } while (0)
struct XcdBarrier { unsigned* bar; unsigned x; volatile LAS unsigned* st; };
__device__ __forceinline__ XcdBarrier xcd_barrier_post(unsigned* bar, volatile LAS unsigned* st) {
    XcdBarrier b; b.bar = bar; b.x = xb_xcc_id(); b.st = st;
    if (threadIdx.x == 0) (void)xb_add(&bar[XB_XCNT(b.x)], 1u);
    return b;
}
__device__ __forceinline__ void xcd_barrier_complete(unsigned* bar, unsigned x, unsigned& nloc, unsigned& nx) {
    const unsigned G = gridDim.x * gridDim.y * gridDim.z;
    unsigned sum, cnt, mine, sp = 0u;
    for (;;) {
        sum = 0u; cnt = 0u; mine = 0u;
#pragma unroll
        for (unsigned j = 0; j < 16; ++j) { const unsigned c = xb_ld(&bar[XB_XCNT(j)]); sum += c; cnt += (c > 0u) ? 1u : 0u; mine = (j == x) ? c : mine; }
        if (sum == G) break;
        __builtin_amdgcn_s_sleep(1);
        if ((++sp & 255u) == 0u) { if (xb_ld(&bar[XB_TMO])) break; if (sp > XB_SPIN_CAP) { atomicAdd(&bar[XB_TMO], 1u); break; } }
    }
    nloc = mine > 0u ? mine : 1u; nx = cnt > 0u ? cnt : 1u;
}
__device__ __forceinline__ void xcd_barrier(const XcdBarrier& b) {
    asm volatile("s_waitcnt vmcnt(0)" ::: "memory");
    __syncthreads();
    if (threadIdx.x == 0) {
        unsigned* bar = b.bar;
        __builtin_amdgcn_s_waitcnt(0);
        unsigned nloc = b.st[0], nx = b.st[1];
        if (nloc == 0u) { xcd_barrier_complete(bar, b.x, nloc, nx); b.st[0] = nloc; b.st[1] = nx; }
        const unsigned old = xb_add(&bar[XB_XSUB(b.x)], 1u);
        const unsigned gen = old / nloc;
        if (old + 1u == (gen + 1u) * nloc) {
            __builtin_amdgcn_fence(__ATOMIC_RELEASE, "agent");
            asm volatile("s_waitcnt vmcnt(0)" ::: "memory");
            const unsigned og = xb_add(&bar[XB_TOP], 1u);
            const unsigned tg = og / nx;
            if (og + 1u == (tg + 1u) * nx) xb_add(&bar[XB_TOPGEN], 1u);
            else XB_SPIN(xb_ld(&bar[XB_TOPGEN]) == tg, bar);
            __builtin_amdgcn_fence(__ATOMIC_ACQUIRE, "agent");
            xb_add(&bar[XB_XGEN(b.x)], 1u);
            asm volatile("s_waitcnt vmcnt(0)" ::: "memory");
        } else {
            XB_SPIN(xb_ld(&bar[XB_XGEN(b.x)]) == gen, bar);
            __builtin_amdgcn_fence(__ATOMIC_ACQUIRE, "agent");
            asm volatile("s_waitcnt vmcnt(0)" ::: "memory");
        }
    }
    __syncthreads();
}

namespace pg8 {
constexpr int BM = 256, BK = 64, HALF = 128, HTB = HALF * BK * 2, STAGE_BYTES = 8 * HTB, NXCD = 8, WGM = 8;
__host__ __device__ __forceinline__ int lds_byte(int r, int c) { const int st = (r >> 4) * 2 + (c >> 5), rr = r & 15, cc = c & 31, ob = rr * 64 + cc * 2; return st * 1024 + (ob ^ (((ob >> 9) & 1) << 5)); }
__host__ __device__ __forceinline__ void stage_rc(int b, int& R, int& C) { const int st = b / 1024, sb = b % 1024, swz = sb ^ (((sb >> 9) & 1) << 5); R = (st >> 1) * 16 + swz / 64; C = (st & 1) * 32 + (swz % 64) / 2; }
__host__ __device__ __forceinline__ int perm32(int rho) { const int n = rho >> 4, i = rho & 15; return 8 * (i >> 2) + 4 * n + (i & 3); }
struct Unit { int pm, pn, pc, hf; };
struct Gemm { const bf16_t* A; const bf16_t* Bt; int K; };
struct StaticOrder {
    int nM, nMf, nN, nwgF, nwg, G, c;
    __device__ void init(int M, int N, int G_, int c_, int Mfull = -1) { nM = M / BM; nMf = (Mfull < 0 ? M : Mfull) / BM; nN = N / BM; nwgF = nMf * nN; nwg = nwgF + 2 * (nM - nMf) * nN; G = G_; c = c_; }
    __device__ bool next(int i, Unit& u) const {
        const long L = (long)i * G + c; if (L >= nwg) return false;
        if (L < nwgF) {
            int wgid = (int)L; { const int q = nwgF / NXCD, r = nwgF % NXCD, xcd = wgid % NXCD, off = wgid / NXCD; wgid = (xcd < r ? xcd * (q + 1) : r * (q + 1) + (xcd - r) * q) + off; }
            const int nig = WGM * nN, gid = wgid / nig, fm = gid * WGM, gsz = (nMf - fm) < WGM ? (nMf - fm) : WGM;
            u.pm = fm + ((wgid % nig) % gsz); u.pn = (wgid % nig) / gsz; u.hf = 0;
        } else { const int r = (int)L - nwgF, xcd = r % NXCD, j = r / NXCD, nT2 = 2 * (nM - nMf), perX = (nwg - nwgF) / NXCD, idx = xcd * perX + j;
            u.pn = idx / nT2; u.pm = nMf + ((idx % nT2) >> 1); u.hf = 1 + (idx & 1); }
        u.pc = u.pn; return true;
    }
    __device__ __forceinline__ void a_ready(const Unit&) const {}
    __device__ __forceinline__ void done(const Unit&) const {}
};
template <int CN0>
struct StaticOrderTailCols {
    int nM, nMf, nN, nwgF, nwg, G, c;
    __device__ void init(int M, int N, int G_, int c_, int Mfull) { nM = M / BM; nMf = Mfull / BM; nN = N / BM; nwgF = nMf * nN; nwg = nwgF + (nM - nMf) * (nN - CN0); G = G_; c = c_; }
    __device__ bool next(int i, Unit& u) const {
        const long L = (long)i * G + c; if (L >= nwg) return false;
        if (L < nwgF) {
            int wgid = (int)L; { const int q = nwgF / NXCD, r = nwgF % NXCD, xcd = wgid % NXCD, off = wgid / NXCD; wgid = (xcd < r ? xcd * (q + 1) : r * (q + 1) + (xcd - r) * q) + off; }
            const int nig = WGM * nN, gid = wgid / nig, fm = gid * WGM, gsz = (nMf - fm) < WGM ? (nMf - fm) : WGM;
            u.pm = fm + ((wgid % nig) % gsz); u.pn = (wgid % nig) / gsz;
        } else { const int r = (int)L - nwgF, nT = nM - nMf; u.pm = nMf + r % nT; u.pn = CN0 + r / nT; }
        u.pc = u.pn; u.hf = 0; return true;
    }
    __device__ __forceinline__ void a_ready(const Unit&) const {}
    __device__ __forceinline__ void done(const Unit&) const {}
};
struct MoeOrder {
    int RT, RTf, CT, nwg, G, c;
    __device__ void init(int RT_, int CT_, int G_, int c_, int RTf_ = -1) { RT = RT_; RTf = RTf_ < 0 ? RT_ : RTf_; CT = CT_; nwg = NE * RT * CT; G = G_; c = c_; }
    __device__ bool next(int i, Unit& u) const {
        const long L0 = (long)i * G + c; if (L0 >= nwg) return false;
        int L = (int)L0; { const int q = nwg / NXCD, r = nwg % NXCD, xcd = L % NXCD, off = L / NXCD; L = (xcd < r ? xcd * (q + 1) : r * (q + 1) + (xcd - r) * q) + off; }
        const int per = RT * CT, e = L / per, rem = L % per, pnl = rem / RT, pml = rem % RT;
        u.pm = e * RT + pml; u.pn = e * CT + pnl; u.pc = pnl; u.hf = pml >= RTf ? 1 : 0; return true;
    }
    __device__ __forceinline__ void a_ready(const Unit&) const {}
    __device__ __forceinline__ void done(const Unit&) const {}
};

template <class Epi, class Sched, bool GATHER = false>
__device__ __forceinline__ void gemm_phase(LAS unsigned char* lds, const Gemm g, const Sched& S, const Epi& E, const int* src = nullptr) {
    const int tid = threadIdx.x, wid = __builtin_amdgcn_readfirstlane(tid >> 6), lane = tid & 63, wr = wid >> 2, wc = wid & 3, fr = lane & 15, fq = lane >> 4;
    const int K = g.K, nt = K / BK;
    unsigned voffA[2][2], voffN[2][2], voffB[2];
    int stR[2], stC[2];
#pragma unroll
    for (int i = 0; i < 2; ++i) { int R, C; stage_rc(tid * 16 + i * 8192, R, C); stR[i] = R; stC[i] = C; const int Rb = Epi::PERM ? ((R & ~31) + perm32(R & 31)) : R;
        voffA[0][i] = (unsigned)(R * K + C) * 2u; voffA[1][i] = voffA[0][i]; voffN[0][i] = voffA[0][i]; voffN[1][i] = voffA[0][i]; voffB[i] = (unsigned)(Rb * K + C) * 2u; }
    const size_t kstep = (size_t)(BK * 2);
    const size_t hstep = (size_t)HALF * K * 2;
    const size_t tstep = 2 * hstep;
    const size_t hstepA = GATHER ? 0 : hstep;
    const unsigned ldsw = (unsigned)wid * 1024u;
    const int aoff = lds_byte(wr * 64 + fr, fq * 8), boff = lds_byte(wc * 32 + fr, fq * 8);
#define PG8_SA(b, h) (((b) * 2 + (h)) * HTB)
#define PG8_SB(b, h) ((4 + (b) * 2 + (h)) * HTB)
#define PG8_STAGE(bufoff, gbase, voff) do { _Pragma("unroll") for (int _i = 0; _i < 2; ++_i) \
        __builtin_amdgcn_global_load_lds((const unsigned*)((const char*)(gbase) + (voff)[_i]), (LAS unsigned*)(lds + (bufoff) + ldsw + _i * 8192), 16, 0, 0); } while (0)
#define PG8_GOFF(dst, pmv) do { if (GATHER) { _Pragma("unroll") for (int _h = 0; _h < 2; ++_h) _Pragma("unroll") for (int _i = 0; _i < 2; ++_i) \
        dst[_h][_i] = ((unsigned)src[(pmv) * BM + _h * HALF + stR[_i]] * (unsigned)K + (unsigned)stC[_i]) * 2u; } } while (0)
#define PG8_LDA(dst, b, h) do { _Pragma("unroll") for (int m = 0; m < 4; ++m) _Pragma("unroll") for (int k = 0; k < 2; ++k) dst[m][k] = *(const LAS bf16x8*)(lds + PG8_SA(b, h) + aoff + m * 2048 + k * 1024); } while (0)
#define PG8_LDB(dst, b, h) do { _Pragma("unroll") for (int n = 0; n < 2; ++n) _Pragma("unroll") for (int k = 0; k < 2; ++k) dst[n][k] = *(const LAS bf16x8*)(lds + PG8_SB(b, h) + boff + n * 2048 + k * 1024); } while (0)
#define PG8_MMA(ai, bj, At, Bt) do { __builtin_amdgcn_s_setprio(1); _Pragma("unroll") for (int m = 0; m < 4; ++m) _Pragma("unroll") for (int n = 0; n < 2; ++n) _Pragma("unroll") for (int k = 0; k < 2; ++k) \
        acc[ai][bj][m][n] = __builtin_amdgcn_mfma_f32_16x16x32_bf16(Bt[n][k], At[m][k], acc[ai][bj][m][n], 0, 0, 0); __builtin_amdgcn_s_setprio(0); } while (0)
#define PG8_WAIT_V(n) asm volatile("s_waitcnt vmcnt(" #n ")" ::: "memory")
#define PG8_WAIT_L(n) asm volatile("s_waitcnt lgkmcnt(" #n ")" ::: "memory")
#define PG8_BAR __builtin_amdgcn_s_barrier()
#define PG8_SCHED __builtin_amdgcn_sched_barrier(0)
    Unit cur, nxt; int ui = 0;
    if (!S.next(0, cur)) return;
    f32x4 acc[2][2][4][2];
#pragma unroll
    for (int a = 0; a < 2; ++a)
#pragma unroll
        for (int b = 0; b < 2; ++b)
#pragma unroll
            for (int m = 0; m < 4; ++m)
#pragma unroll
                for (int n = 0; n < 2; ++n) acc[a][b][m][n] = (f32x4){0.f, 0.f, 0.f, 0.f};
    bf16x8 At[4][2], B0[2][2], B1[2][2];
#define PG8_ABASE(u) ((const char*)g.A + (GATHER ? (size_t)0 : (size_t)(u).pm * tstep + ((u).hf == 2 ? hstep : (size_t)0)))
    const char* cA = PG8_ABASE(cur); const char* cB = (const char*)g.Bt + (size_t)cur.pn * tstep;
    size_t cHA = cur.hf ? (size_t)0 : hstepA; bool full = cur.hf == 0;
    PG8_GOFF(voffA, cur.pm);
    S.a_ready(cur);
    PG8_STAGE(PG8_SB(0, 0), cB, voffB); PG8_STAGE(PG8_SA(0, 0), cA, voffA[0]); PG8_STAGE(PG8_SB(0, 1), cB + hstep, voffB); PG8_STAGE(PG8_SA(0, 1), cA + cHA, voffA[1]);
    if (wr == 1) PG8_BAR;
    PG8_WAIT_V(4); PG8_BAR;
    PG8_STAGE(PG8_SB(1, 0), cB + kstep, voffB); PG8_STAGE(PG8_SA(1, 0), cA + kstep, voffA[0]); PG8_STAGE(PG8_SB(1, 1), cB + hstep + kstep, voffB);
    PG8_WAIT_V(6); PG8_BAR;
    for (;;) {
        const bool has_next = S.next(ui + 1, nxt);
        const size_t nHA = has_next ? (nxt.hf ? (size_t)0 : hstepA) : cHA;
        const char* nA = (has_next && !GATHER) ? PG8_ABASE(nxt) : cA; const char* nB = has_next ? (const char*)g.Bt + (size_t)nxt.pn * tstep : cB;
        if (GATHER) { if (has_next) PG8_GOFF(voffN, nxt.pm); else {
#pragma unroll
            for (int _h = 0; _h < 2; ++_h)
#pragma unroll
                for (int _i = 0; _i < 2; ++_i) voffN[_h][_i] = voffA[_h][_i]; } }
        for (int t = 0; t < nt; t += 2) {
            const bool last = (t == nt - 2);
            const char* a1 = cA + (size_t)(t + 1) * kstep;
            const char* a2 = last ? nA : cA + (size_t)(t + 2) * kstep; const char* b2 = last ? nB : cB + (size_t)(t + 2) * kstep;
            const char* a3 = a2 + kstep; const char* b3 = b2 + kstep;
            unsigned va2[2][2];
#pragma unroll
            for (int _h = 0; _h < 2; ++_h)
#pragma unroll
                for (int _i = 0; _i < 2; ++_i) va2[_h][_i] = (GATHER && last) ? voffN[_h][_i] : voffA[_h][_i];
            if (last && has_next) S.a_ready(nxt);
            PG8_LDB(B0, 0, 0); PG8_SCHED; PG8_LDA(At, 0, 0); PG8_STAGE(PG8_SA(1, 1), a1 + cHA, voffA[1]);
            PG8_WAIT_L(8); PG8_BAR; PG8_WAIT_L(0); PG8_MMA(0, 0, At, B0); PG8_BAR; PG8_SCHED;
            PG8_LDB(B1, 0, 1); PG8_STAGE(PG8_SB(0, 0), b2, voffB);
            PG8_BAR; PG8_WAIT_L(0); PG8_MMA(0, 1, At, B1); PG8_BAR;
            if (full) PG8_LDA(At, 0, 1); PG8_STAGE(PG8_SA(0, 0), a2, va2[0]);
            PG8_BAR; PG8_WAIT_L(0); if (full) PG8_MMA(1, 0, At, B0); PG8_BAR; PG8_SCHED;
            PG8_STAGE(PG8_SB(0, 1), b2 + hstep, voffB);
            PG8_WAIT_V(6); PG8_BAR; if (full) PG8_MMA(1, 1, At, B1); PG8_BAR;
            PG8_LDB(B0, 1, 0); PG8_SCHED; PG8_LDA(At, 1, 0); PG8_STAGE(PG8_SA(0, 1), a2 + (last ? nHA : cHA), va2[1]);
            PG8_WAIT_L(8); PG8_BAR; PG8_WAIT_L(0); PG8_MMA(0, 0, At, B0); PG8_BAR; PG8_SCHED;
            PG8_LDB(B1, 1, 1); PG8_STAGE(PG8_SB(1, 0), b3, voffB);
            PG8_BAR; PG8_WAIT_L(0); PG8_MMA(0, 1, At, B1); PG8_BAR;
            if (full) PG8_LDA(At, 1, 1); PG8_STAGE(PG8_SA(1, 0), a3, va2[0]);
            PG8_BAR; PG8_WAIT_L(0); if (full) PG8_MMA(1, 0, At, B0); PG8_BAR; PG8_SCHED;
            PG8_STAGE(PG8_SB(1, 1), b3 + hstep, voffB);
            PG8_WAIT_V(6); PG8_BAR; if (full) PG8_MMA(1, 1, At, B1); PG8_BAR;
        }
        E(acc, cur, wr, wc, fr, fq); S.done(cur);
        if (!has_next) break;
#pragma unroll
        for (int a = 0; a < 2; ++a)
#pragma unroll
            for (int b = 0; b < 2; ++b)
#pragma unroll
                for (int m = 0; m < 4; ++m)
#pragma unroll
                    for (int n = 0; n < 2; ++n) acc[a][b][m][n] = (f32x4){0.f, 0.f, 0.f, 0.f};
        cur = nxt; cA = nA; cB = nB; cHA = nHA; full = cur.hf == 0; ++ui;
        if (GATHER) {
#pragma unroll
            for (int _h = 0; _h < 2; ++_h)
#pragma unroll
                for (int _i = 0; _i < 2; ++_i) voffA[_h][_i] = voffN[_h][_i]; }
    }
    PG8_WAIT_V(0);
    if (wr == 0) PG8_BAR;
    PG8_BAR;
#undef PG8_SA
#undef PG8_SB
#undef PG8_STAGE
#undef PG8_GOFF
#undef PG8_ABASE
#undef PG8_LDA
#undef PG8_LDB
#undef PG8_MMA
#undef PG8_WAIT_V
#undef PG8_WAIT_L
#undef PG8_BAR
#undef PG8_SCHED
}

struct BSrcF32 { const float* b0; const float* b1; int CT, cstep, hoff; };
template <class Epi, class Sched, bool GATHER, bool HALFU = false>
__device__ __forceinline__ void gemm_phase_fb(LAS unsigned char* lds, const Gemm g, const BSrcF32 bs, const Sched& S, const Epi& E, const int* src = nullptr) {
    static_assert(Epi::PERM, "gemm_phase_fb: permuted weight columns only");
    const int tid = threadIdx.x, wid = __builtin_amdgcn_readfirstlane(tid >> 6), lane = tid & 63, wr = wid >> 2, wc = wid & 3, fr = lane & 15, fq = lane >> 4;
    const int K = g.K, nt = K / BK;
    unsigned voffA[2][2], voffN[2][2];
#pragma unroll
    for (int i = 0; i < 2; ++i) { int R, C; stage_rc(tid * 16 + i * 8192, R, C);
        voffA[0][i] = (unsigned)(R * K + C) * 2u; voffA[1][i] = voffA[0][i]; voffN[0][i] = voffA[0][i]; voffN[1][i] = voffA[0][i]; }
    const size_t kstep = (size_t)(BK * 2);
    const size_t hstep = (size_t)HALF * K * 2;
    const size_t tstep = 2 * hstep;
    const size_t hstepA = GATHER ? 0 : hstep;
    const size_t kstepB = (size_t)BK * 2048 * 4;
    const unsigned ldsw = (unsigned)wid * 1024u;
    const int aoff = lds_byte(wr * 64 + fr, fq * 8);
    const unsigned gvoff = (unsigned)(((tid >> 5) * 2048 + (tid & 31) * 4) * 4);
    unsigned bwoff;
    { const int k0 = tid >> 5, c = 4 * (tid & 31), c5 = c & 31, cp = (c & ~31) + 16 * ((c5 >> 2) & 1) + 4 * (c5 >> 3);
        const int X = ((k0 & 3) << 2) | ((k0 >> 2) & 3); bwoff = (unsigned)(256 * k0 + 16 * ((cp >> 3) ^ X) + 8 * ((cp >> 2) & 1)); }
    const unsigned bwaddr = (unsigned)(size_t)lds + 4 * HTB + bwoff;
    unsigned braddr[2][2];
#pragma unroll
    for (int t = 0; t < 2; ++t) { const int row = 8 * fq + 4 * t + (fr >> 2), X_ = ((row & 3) << 2) | ((row >> 2) & 3), ch = 2 * (2 * wc) + ((lane & 3) >> 1);
        const unsigned o = (unsigned)(256 * row + 16 * (ch ^ X_) + 8 * (lane & 1));
        braddr[t][0] = (unsigned)(size_t)lds + 4 * HTB + o; braddr[t][1] = (unsigned)(size_t)lds + 4 * HTB + (o ^ 32u); }
#define PG8_SA(b, h) (((b) * 2 + (h)) * HTB)
#define PG8_SB(b, h) ((4 + (b) * 2 + (h)) * HTB)
#define PG8_STAGE(bufoff, gbase, voff) do { _Pragma("unroll") for (int _i = 0; _i < 2; ++_i) \
        __builtin_amdgcn_global_load_lds((const unsigned*)((const char*)(gbase) + (voff)[_i]), (LAS unsigned*)(lds + (bufoff) + ldsw + _i * 8192), 16, 0, 0); } while (0)
#define PG8_GOFF(dst, pmv) do { if (GATHER) { _Pragma("unroll") for (int _h = 0; _h < 2; ++_h) _Pragma("unroll") for (int _i = 0; _i < 2; ++_i) { int _R, _C; stage_rc(tid * 16 + _i * 8192, _R, _C); \
        dst[_h][_i] = ((unsigned)src[(pmv) * BM + _h * HALF + _R] * (unsigned)K + (unsigned)_C) * 2u; } } } while (0)
#define PG8_BGL(dst, gbase) do { _Pragma("unroll") for (int _i = 0; _i < 4; ++_i) { const char* _b = (const char*)(gbase) + _i * 131072; \
        asm volatile("global_load_dwordx4 %0, %1, %2" : "=v"(dst[_i]) : "v"(gvoff), "s"(_b) : "memory"); } } while (0)
#define PG8_WAIT_VX(n, r) asm volatile("s_waitcnt vmcnt(" #n ")" : "+v"(r[0]), "+v"(r[1]), "+v"(r[2]), "+v"(r[3]) :: "memory")
#define PG8_BWR(srcv, b, h) do { _Pragma("unroll") for (int _i = 0; _i < 4; ++_i) { u32x2 _w; _w.x = pk2(srcv[_i][0], srcv[_i][1]); _w.y = pk2(srcv[_i][2], srcv[_i][3]); \
        asm volatile("ds_write_b64 %0, %1 offset:%2" :: "v"(bwaddr), "v"(_w), "n"(((b) * 2 + (h)) * HTB + _i * 4096) : "memory"); } } while (0)
#define PG8_LDA(dst, b, h) do { _Pragma("unroll") for (int m = 0; m < 4; ++m) _Pragma("unroll") for (int k = 0; k < 2; ++k) dst[m][k] = *(const LAS bf16x8*)(lds + PG8_SA(b, h) + aoff + m * 2048 + k * 1024); } while (0)
#define PG8_LDB(dst, b, h) do { _Pragma("unroll") for (int n = 0; n < 2; ++n) _Pragma("unroll") for (int k = 0; k < 2; ++k) { s16x4 _lo, _hi; \
            asm volatile("ds_read_b64_tr_b16 %0, %1 offset:%2" : "=v"(_lo) : "v"(braddr[0][n]), "n"(((b) * 2 + (h)) * HTB + k * 8192) : "memory"); \
            asm volatile("ds_read_b64_tr_b16 %0, %1 offset:%2" : "=v"(_hi) : "v"(braddr[1][n]), "n"(((b) * 2 + (h)) * HTB + k * 8192) : "memory"); \
            dst[n][k] = __builtin_shufflevector(_lo, _hi, 0, 1, 2, 3, 4, 5, 6, 7); } } while (0)
#define PG8_WAIT_LB(Bx) asm volatile("s_waitcnt lgkmcnt(0)" : "+v"(Bx[0][0]), "+v"(Bx[0][1]), "+v"(Bx[1][0]), "+v"(Bx[1][1]) :: "memory")
#define PG8_MMA(ai, bj, At, Bt) do { __builtin_amdgcn_s_setprio(1); _Pragma("unroll") for (int m = 0; m < 4; ++m) _Pragma("unroll") for (int n = 0; n < 2; ++n) _Pragma("unroll") for (int k = 0; k < 2; ++k) \
        acc[ai][bj][m][n] = __builtin_amdgcn_mfma_f32_16x16x32_bf16(Bt[n][k], At[m][k], acc[ai][bj][m][n], 0, 0, 0); __builtin_amdgcn_s_setprio(0); } while (0)
#define PG8_WAIT_V(n) asm volatile("s_waitcnt vmcnt(" #n ")" ::: "memory")
#define PG8_WAIT_L(n) asm volatile("s_waitcnt lgkmcnt(" #n ")" ::: "memory")
#define PG8_BAR __builtin_amdgcn_s_barrier()
#define PG8_SCHED __builtin_amdgcn_sched_barrier(0)
#define PG8_BPTR(dst, u) do { const float* _e0 = bs.b0 + (size_t)((u).pn / bs.CT) * 2048 * 2048 + (size_t)(u).pc * bs.cstep; const float* _e1 = bs.b1 + (size_t)((u).pn / bs.CT) * 2048 * 2048 + (size_t)(u).pc * bs.cstep + bs.hoff; \
        dst[0] = (const char*)_e0; dst[1] = (const char*)_e1; } while (0)
    Unit cur, nxt; int ui = 0;
    if (!S.next(0, cur)) return;
    f32x4 acc[2][2][4][2];
#pragma unroll
    for (int a = 0; a < 2; ++a)
#pragma unroll
        for (int b = 0; b < 2; ++b)
#pragma unroll
            for (int m = 0; m < 4; ++m)
#pragma unroll
                for (int n = 0; n < 2; ++n) acc[a][b][m][n] = (f32x4){0.f, 0.f, 0.f, 0.f};
    bf16x8 At[4][2], B0[2][2], B1[2][2];
    f32x4 X[4];
#define PG8_ABASE(u) ((const char*)g.A + (GATHER ? (size_t)0 : (size_t)(u).pm * tstep + ((u).hf == 2 ? hstep : (size_t)0)))
    const char* cA = PG8_ABASE(cur);
    size_t cHA = (HALFU && cur.hf) ? (size_t)0 : hstepA; bool full = !HALFU || cur.hf == 0;
    const char* cB[2]; PG8_BPTR(cB, cur);
    PG8_GOFF(voffA, cur.pm);
    S.a_ready(cur);
    PG8_STAGE(PG8_SA(0, 0), cA, voffA[0]); PG8_STAGE(PG8_SA(0, 1), cA + cHA, voffA[1]);
    PG8_BGL(X, cB[0]); PG8_WAIT_VX(0, X); PG8_BWR(X, 0, 0);
    PG8_BGL(X, cB[1]); PG8_WAIT_VX(0, X); PG8_BWR(X, 0, 1);
    if (wr == 1) PG8_BAR;
    PG8_BGL(X, cB[0] + kstepB); PG8_WAIT_VX(0, X); PG8_BWR(X, 1, 0);
    PG8_WAIT_L(0); PG8_BAR;
    PG8_STAGE(PG8_SA(1, 0), cA + kstep, voffA[0]); PG8_BGL(X, cB[1] + kstepB);
    PG8_BAR;
    for (;;) {
        const bool has_next = S.next(ui + 1, nxt);
        const size_t nHA = (HALFU && has_next) ? (nxt.hf ? (size_t)0 : hstepA) : cHA;
        const char* nA = (has_next && !GATHER) ? PG8_ABASE(nxt) : cA;
        const char* nB[2]; nB[0] = cB[0]; nB[1] = cB[1]; if (has_next) PG8_BPTR(nB, nxt);
        if (GATHER) { if (has_next) PG8_GOFF(voffN, nxt.pm); else {
#pragma unroll
            for (int _h = 0; _h < 2; ++_h)
#pragma unroll
                for (int _i = 0; _i < 2; ++_i) voffN[_h][_i] = voffA[_h][_i]; } }
        for (int t = 0; t < nt; t += 2) {
            const bool last = (t == nt - 2);
            const char* a1 = cA + (size_t)(t + 1) * kstep;
            const char* a2 = last ? nA : cA + (size_t)(t + 2) * kstep;
            const char* a3 = a2 + kstep;
            const char* b20 = last ? nB[0] : cB[0] + (size_t)(t + 2) * kstepB; const char* b21 = last ? nB[1] : cB[1] + (size_t)(t + 2) * kstepB;
            unsigned va2[2][2];
#pragma unroll
            for (int _h = 0; _h < 2; ++_h)
#pragma unroll
                for (int _i = 0; _i < 2; ++_i) va2[_h][_i] = (GATHER && last) ? voffN[_h][_i] : voffA[_h][_i];
            if (last && has_next) S.a_ready(nxt);
            PG8_LDB(B0, 0, 0); PG8_SCHED; PG8_LDA(At, 0, 0); PG8_STAGE(PG8_SA(1, 1), a1 + cHA, voffA[1]);
            PG8_WAIT_L(8); PG8_BAR; PG8_WAIT_LB(B0); PG8_MMA(0, 0, At, B0); PG8_BAR; PG8_SCHED;
            PG8_WAIT_VX(2, X); PG8_BWR(X, 1, 1);
            PG8_LDB(B1, 0, 1); PG8_BGL(X, b20);
            PG8_BAR; PG8_WAIT_LB(B1); PG8_MMA(0, 1, At, B1); PG8_BAR;
            if (full) PG8_LDA(At, 0, 1); PG8_STAGE(PG8_SA(0, 0), a2, va2[0]);
            PG8_BAR; PG8_WAIT_L(0); if (full) PG8_MMA(1, 0, At, B0); PG8_BAR; PG8_SCHED;
            PG8_WAIT_VX(2, X); PG8_BWR(X, 0, 0);
            PG8_BGL(X, b21);
            PG8_WAIT_L(0); PG8_BAR; if (full) PG8_MMA(1, 1, At, B1); PG8_BAR;
            PG8_LDB(B0, 1, 0); PG8_SCHED; PG8_LDA(At, 1, 0); PG8_STAGE(PG8_SA(0, 1), a2 + (last ? nHA : cHA), va2[1]);
            PG8_WAIT_L(8); PG8_BAR; PG8_WAIT_LB(B0); PG8_MMA(0, 0, At, B0); PG8_BAR; PG8_SCHED;
            PG8_WAIT_VX(2, X); PG8_BWR(X, 0, 1);
            PG8_LDB(B1, 1, 1); PG8_BGL(X, b20 + kstepB);
            PG8_BAR; PG8_WAIT_LB(B1); PG8_MMA(0, 1, At, B1); PG8_BAR;
            if (full) PG8_LDA(At, 1, 1); PG8_STAGE(PG8_SA(1, 0), a3, va2[0]);
            PG8_BAR; PG8_WAIT_L(0); if (full) PG8_MMA(1, 0, At, B0); PG8_BAR; PG8_SCHED;
            PG8_WAIT_VX(2, X); PG8_BWR(X, 1, 0);
            PG8_BGL(X, b21 + kstepB);
            PG8_WAIT_L(0); PG8_BAR; if (full) PG8_MMA(1, 1, At, B1); PG8_BAR;
        }
        { int tz = threadIdx.x; asm volatile("" : "+v"(tz)); const int wz = __builtin_amdgcn_readfirstlane(tz >> 6); E(acc, cur, wz >> 2, wz & 3, tz & 15, (tz & 63) >> 4); } S.done(cur);
        if (!has_next) break;
#pragma unroll
        for (int a = 0; a < 2; ++a)
#pragma unroll
            for (int b = 0; b < 2; ++b)
#pragma unroll
                for (int m = 0; m < 4; ++m)
#pragma unroll
                    for (int n = 0; n < 2; ++n) acc[a][b][m][n] = (f32x4){0.f, 0.f, 0.f, 0.f};
        cur = nxt; cA = nA; cB[0] = nB[0]; cB[1] = nB[1]; cHA = nHA; full = !HALFU || cur.hf == 0; ++ui;
        if (GATHER) {
#pragma unroll
            for (int _h = 0; _h < 2; ++_h)
#pragma unroll
                for (int _i = 0; _i < 2; ++_i) voffA[_h][_i] = voffN[_h][_i]; }
    }
    PG8_WAIT_V(0);
    if (wr == 0) PG8_BAR;
    PG8_BAR;
#undef PG8_SA
#undef PG8_SB
#undef PG8_STAGE
#undef PG8_GOFF
#undef PG8_ABASE
#undef PG8_BGL
#undef PG8_WAIT_VX
#undef PG8_BWR
#undef PG8_LDA
#undef PG8_LDB
#undef PG8_WAIT_LB
#undef PG8_MMA
#undef PG8_WAIT_V
#undef PG8_WAIT_L
#undef PG8_BAR
#undef PG8_SCHED
#undef PG8_BPTR
}

struct EpiStore {
    static constexpr bool PERM = true;
    bf16_t* O; int ldc;
    __device__ __forceinline__ void operator()(const f32x4 (&acc)[2][2][4][2], const Unit& u, int wr, int wc, int fr, int fq) const {
        const int row0 = u.pm * BM + (u.hf == 2 ? HALF : 0) + wr * 64 + fr, col0 = u.pc * BM + wc * 32 + 8 * fq;
#pragma unroll
        for (int ai = 0; ai < 2; ++ai) if (ai == 0 || u.hf == 0)
#pragma unroll
            for (int m = 0; m < 4; ++m) { bf16_t* rowp = O + (size_t)(row0 + ai * HALF + m * 16) * ldc + col0;
#pragma unroll
                for (int bj = 0; bj < 2; ++bj) { const f32x4 v0 = acc[ai][bj][m][0], v1 = acc[ai][bj][m][1];
                    u32x4 w; w.x = pk2(v0[0], v0[1]); w.y = pk2(v0[2], v0[3]); w.z = pk2(v1[0], v1[1]); w.w = pk2(v1[2], v1[3]);
                    *(u32x4*)(rowp + bj * HALF) = w; } }
    }
};
struct EpiSiluMul {
    static constexpr bool PERM = true;
    bf16_t* O;
    __device__ __forceinline__ void operator()(const f32x4 (&acc)[2][2][4][2], const Unit& u, int wr, int wc, int fr, int fq) const {
        const int row0 = u.pm * BM + (u.hf == 2 ? HALF : 0) + wr * 64 + fr, col0 = u.pc * HALF + wc * 32 + 8 * fq;
#pragma unroll
        for (int ai = 0; ai < 2; ++ai) if (ai == 0 || u.hf == 0)
#pragma unroll
            for (int m = 0; m < 4; ++m) { bf16_t* rowp = O + (size_t)(row0 + ai * HALF + m * 16) * D + col0;
                float h[8];
#pragma unroll
                for (int n = 0; n < 2; ++n)
#pragma unroll
                    for (int j = 0; j < 4; ++j) { const float gt = acc[ai][0][m][n][j], up = acc[ai][1][m][n][j]; h[n * 4 + j] = gt * __builtin_amdgcn_rcpf(1.f + __expf(-gt)) * up; }
                u32x4 w; w.x = pk2(h[0], h[1]); w.y = pk2(h[2], h[3]); w.z = pk2(h[4], h[5]); w.w = pk2(h[6], h[7]);
                *(u32x4*)rowp = w; }
    }
};
template <bool XIN_BF16>
struct EpiResid {
    static constexpr bool PERM = true;
    const float* xinLat; const float* xinCtx; bf16_t* X1; const float* g1;
    __device__ __forceinline__ void operator()(const f32x4 (&acc)[2][2][4][2], const Unit& u, int wr, int wc, int fr, int fq) const {
        const int row0 = u.pm * BM + (u.hf == 2 ? HALF : 0) + wr * 64 + fr, col0 = u.pc * BM + wc * 32 + 8 * fq;
        const int mrow = u.pm < 64 ? (u.pm >> 4) : 4;
        f32x4 gv[2][2];
#pragma unroll
        for (int bj = 0; bj < 2; ++bj)
#pragma unroll
            for (int n = 0; n < 2; ++n) gv[bj][n] = *(const f32x4*)(g1 + (size_t)mrow * 12288 + col0 + bj * HALF + 4 * n);
#pragma unroll
        for (int ai = 0; ai < 2; ++ai) if (ai == 0 || u.hf == 0)
#pragma unroll
            for (int m = 0; m < 4; ++m) { const int row = row0 + ai * HALF + m * 16;
                bf16_t* orow = X1 + (size_t)row * D + col0;
#pragma unroll
                for (int bj = 0; bj < 2; ++bj) { f32x4 x0, x1;
                    if (XIN_BF16) { const u32x4 w = *(const u32x4*)(orow + bj * HALF); x0 = (f32x4){bflo(w.x), bfhi(w.x), bflo(w.y), bfhi(w.y)}; x1 = (f32x4){bflo(w.z), bfhi(w.z), bflo(w.w), bfhi(w.w)}; }
                    else { const float* xr = (u.pm < 64 ? xinLat + (size_t)row * D : xinCtx + (size_t)(row - M_LAT) * D) + col0 + bj * HALF; x0 = *(const f32x4*)xr; x1 = *(const f32x4*)(xr + 4); }
                    const f32x4 v0 = x0 + gv[bj][0] * acc[ai][bj][m][0], v1 = x1 + gv[bj][1] * acc[ai][bj][m][1];
                    u32x4 w; w.x = pk2(v0[0], v0[1]); w.y = pk2(v0[2], v0[3]); w.z = pk2(v1[0], v1[1]); w.w = pk2(v1[2], v1[3]);
                    *(u32x4*)(orow + bj * HALF) = w; } }
    }
};
}

struct Args { const float* in[26]; float* out; unsigned char* ws; int lo, hi; };
enum { I_X = 0, I_C, I_CTX, I_CCTX, I_ADAW, I_ADAB, I_NMIX, I_NFFN, I_NFIN, I_EVIN, I_EVOUT, I_GAMMA, I_RETN, I_GMLPN, I_GMLPW, I_GMLPB,
       I_ODIN, I_ODOUT, I_RPB, I_GLAWUP, I_GLABUP, I_GLAN, I_ROUTER, I_WGATE, I_WUP, I_WDOWN };

__device__ __forceinline__ void phase_prologue(const Args& a, LAS unsigned char* lds) {
    const int tid = threadIdx.x;
    if (blockIdx.x == gridDim.x - 1) {
        float* rc = (float*)(a.ws + WS_ROT); float* rs = rc + 2048;
        for (int i = tid; i < 2048; i += 512) { const int pos = i >> 5, f = i & 31; const float freq = exp2f(-(float)f * 0.41524101186092029f); const float ang = (float)pos * freq;
            rc[i] = __cosf(ang); rs[i] = __sinf(ang); }
    }
    { bf16_t* wb = (bf16_t*)(a.ws + WS_GMW);
        for (int i = blockIdx.x * 512 + tid; i < 8 * 128 * 128 / 2; i += gridDim.x * 512) { const f32x2 v = *(const f32x2*)(a.in[I_GMLPW] + 2 * i); ((unsigned*)wb)[i] = pk2(v[0], v[1]); } }
    LAS float* sc = (LAS float*)lds;
    LAS float* red = (LAS float*)(lds + 40960);
    float* MOD = (float*)(a.ws + WS_MOD);
    if ((int)blockIdx.x < 192) {
        for (int i = tid; i < 5 * 2048; i += 512) { const int r = i >> 11, k = i & 2047; const float v = r < 4 ? a.in[I_C][r * 2048 + k] : a.in[I_CCTX][k]; sc[i] = v / (1.f + expf(-v)); }
        __syncthreads();
        const int u = blockIdx.x, l = u / 96, cb = u % 96, cq = tid & 31, kq = tid >> 5;
        const float* w = a.in[I_ADAW] + (size_t)l * 2048 * 12288 + cb * 128 + cq * 4;
        f32x4 acc[5];
#pragma unroll
        for (int r = 0; r < 5; ++r) acc[r] = (f32x4){0.f, 0.f, 0.f, 0.f};
        for (int j0 = 0; j0 < 128; j0 += 16) {
            f32x4 wv[16];
#pragma unroll
            for (int j = 0; j < 16; ++j) wv[j] = *(const f32x4*)(w + (size_t)(kq + 16 * (j0 + j)) * 12288);
            __builtin_amdgcn_sched_barrier(0);
#pragma unroll
            for (int j = 0; j < 16; ++j) { const int k = kq + 16 * (j0 + j);
#pragma unroll
                for (int r = 0; r < 5; ++r) acc[r] += sc[r * 2048 + k] * wv[j]; }
        }
#pragma unroll
        for (int r = 0; r < 5; ++r) *(LAS f32x4*)(red + (kq * 5 + r) * 128 + cq * 4) = acc[r];
        __syncthreads();
        for (int o = tid; o < 640; o += 512) { const int r = o >> 7, cc = o & 127; float s = 0.f;
#pragma unroll
            for (int q = 0; q < 16; ++q) s += red[(q * 5 + r) * 128 + cc];
            MOD[(size_t)(l * 5 + r) * 12288 + cb * 128 + cc] = s + a.in[I_ADAB][l * 12288 + cb * 128 + cc]; }
    }
    LAS float* tile = (LAS float*)lds;
    constexpr int CJ0 = 16 * 48, CJ1 = 16 * 16, CJ2 = 16 * 50, CJ3 = 16 * 16, CJM = 32 * 256;
    constexpr int CTOT = CJ0 + CJ1 + CJ2 + CJ3 + 2 * CJM;
    __syncthreads();
    unsigned* cq_head = (unsigned*)(a.ws + WS_CTL) + 8192 + 768;
    volatile LAS int* qs = (volatile LAS int*)(lds + 128 * 129 * 4);
    int pend = 0, it = 0;
    if (tid == 0) { qs[0] = (int)xb_add(cq_head, 1u); pend = (int)xb_add(cq_head, 1u); }
    __syncthreads();
    for (int u = qs[0]; u < CTOT; u = qs[it & 1]) {
        int r = u; const float* src; int ldn, nvalid, NT, mode = 0; bf16_t* dst;
        if (r < CJ0) { src = a.in[I_EVIN]; ldn = 6144; nvalid = 6144; NT = 48; dst = (bf16_t*)(a.ws + WS_WIN0); }
        else if ((r -= CJ0) < CJ1) { src = a.in[I_EVOUT]; ldn = 2048; nvalid = 2048; NT = 16; dst = (bf16_t*)(a.ws + WS_WOUT0); }
        else if ((r -= CJ1) < CJ2) { src = a.in[I_ODIN]; ldn = 6176; nvalid = 6176; NT = 50; dst = (bf16_t*)(a.ws + WS_WIN1); }
        else if ((r -= CJ2) < CJ3) { src = a.in[I_ODOUT]; ldn = 2048; nvalid = 2048; NT = 16; dst = (bf16_t*)(a.ws + WS_WOUT1); }
        else { r -= CJ3; const int which = r / CJM; r -= which * CJM; const int mtx = r >> 8; r &= 255; ldn = 2048; nvalid = 2048; NT = 16;
            if (which == 0) { src = a.in[I_WGATE] + (size_t)mtx * 2048 * 2048; dst = (bf16_t*)(a.ws + WS_WGU) + (size_t)mtx * 4096 * 2048; mode = 1; }
            else if (which == 1) { src = a.in[I_WUP] + (size_t)mtx * 2048 * 2048; dst = (bf16_t*)(a.ws + WS_WGU) + (size_t)mtx * 4096 * 2048; mode = 2; }
            else { src = a.in[I_WDOWN] + (size_t)mtx * 2048 * 2048; dst = (bf16_t*)(a.ws + WS_WDN) + (size_t)mtx * 2048 * 2048; } }
        const int kt = r / NT, ntl = r % NT, k0 = kt * 128, n0 = ntl * 128;
        const int drow0 = mode == 0 ? n0 : (ntl * 256 + (mode == 2 ? 128 : 0));
        f32x4 v[8];
#pragma unroll
        for (int i = 0; i < 8; ++i) { const int id = tid + 512 * i, row = id >> 5, c4 = id & 31, n = n0 + c4 * 4;
            v[i] = (f32x4){0.f, 0.f, 0.f, 0.f};
            if (n < nvalid) v[i] = *(const f32x4*)(src + (size_t)(k0 + row) * ldn + n); }
#pragma unroll
        for (int i = 0; i < 8; ++i) { const int id = tid + 512 * i, row = id >> 5, c4 = id & 31;
            LAS float* tp = tile + row * 129 + c4 * 4; tp[0] = v[i][0]; tp[1] = v[i][1]; tp[2] = v[i][2]; tp[3] = v[i][3]; }
        lds_barrier();
#pragma unroll
        for (int i = 0; i < 4; ++i) { const int piece = tid + 512 * i, nl = piece >> 4, kg = piece & 15; const LAS float* s = tile + (kg * 8) * 129 + nl;
            u32x4 o; o.x = pk2(s[0], s[129]); o.y = pk2(s[258], s[387]); o.z = pk2(s[516], s[645]); o.w = pk2(s[774], s[903]);
            *(u32x4*)(dst + (size_t)(drow0 + nl) * 2048 + k0 + kg * 8) = o; }
        ++it;
        if (tid == 0) { qs[it & 1] = pend; pend = (int)xb_add(cq_head, 1u); }
        lds_barrier();
    }
}

__device__ __forceinline__ void phase_modnorm(const float* srcLat, const float* srcCtx, int nrows, const float* gain, const float* modl, int sh_off, int sc_off, bf16_t* Hb) {
    const int tid = threadIdx.x, lane = tid & 63, wave = tid >> 6;
    const int RPW = (nrows + (int)gridDim.x - 1) / (int)gridDim.x, rb = blockIdx.x * RPW, re = min(rb + RPW, nrows);
    f32x4 nv[4][2];
    const int r0 = rb + wave;
    if (r0 < re) { const float* xr = r0 < M_LAT ? srcLat + (size_t)r0 * D : srcCtx + (size_t)(r0 - M_LAT) * D;
#pragma unroll
        for (int j = 0; j < 4; ++j) { nv[j][0] = *(const f32x4*)(xr + 8 * (lane + 64 * j)); nv[j][1] = *(const f32x4*)(xr + 8 * (lane + 64 * j) + 4); } }
    f32x4 A[4][2], S[4][2]; int mcur = -1;
    for (int r = r0; r < re; r += 8) {
        const int mrow = r < M_LAT ? (r >> 12) : 4;
        if (mrow != mcur) { mcur = mrow; const float* mr = modl + (size_t)mrow * 12288;
#pragma unroll
            for (int j = 0; j < 4; ++j)
#pragma unroll
                for (int t = 0; t < 2; ++t) { const int k = 8 * (lane + 64 * j) + 4 * t; A[j][t] = *(const f32x4*)(gain + k) * (*(const f32x4*)(mr + sc_off + k) + 1.f); S[j][t] = *(const f32x4*)(mr + sh_off + k); } }
        f32x4 v[4][2]; float ss = 0.f;
#pragma unroll
        for (int j = 0; j < 4; ++j)
#pragma unroll
            for (int t = 0; t < 2; ++t) { v[j][t] = nv[j][t]; ss += (v[j][t][0] * v[j][t][0] + v[j][t][1] * v[j][t][1]) + (v[j][t][2] * v[j][t][2] + v[j][t][3] * v[j][t][3]); }
        const int rn = r + 8;
        if (rn < re) { const float* xn = rn < M_LAT ? srcLat + (size_t)rn * D : srcCtx + (size_t)(rn - M_LAT) * D;
#pragma unroll
            for (int j = 0; j < 4; ++j) { nv[j][0] = *(const f32x4*)(xn + 8 * (lane + 64 * j)); nv[j][1] = *(const f32x4*)(xn + 8 * (lane + 64 * j) + 4); } }
        const float rstd = rsqrtf(wave_sum(ss) * (1.f / D) + EPS);
        bf16_t* orow = Hb + (size_t)r * D;
#pragma unroll
        for (int j = 0; j < 4; ++j) { const f32x4 h0 = v[j][0] * rstd * A[j][0] + S[j][0], h1 = v[j][1] * rstd * A[j][1] + S[j][1];
            u32x4 w; w.x = pk2(h0[0], h0[1]); w.y = pk2(h0[2], h0[3]); w.z = pk2(h1[0], h1[1]); w.w = pk2(h1[2], h1[3]);
            *(u32x4*)(orow + 8 * (lane + 64 * j)) = w; }
    }
}

constexpr int RT_HRS = 4096 + 16, RT_WRS = 4096 + 16;
constexpr int RT_H = 0, RT_W = 16 * RT_HRS, RT_RED = RT_W + 16 * RT_WRS, RT_END = RT_RED + 8 * 1024;
static_assert(RT_END <= LDS_BARW, "router LDS map");
__device__ __forceinline__ void phase_modnorm_router(const bf16_t* X1, int nrows, const float* gain, const float* modl, int sh_off, int sc_off,
                                                     bf16_t* Hb, const float* router_w, float* aff, LAS unsigned char* lds) {
    const int tid = threadIdx.x, lane = tid & 63, wv = __builtin_amdgcn_readfirstlane(tid >> 6);
    const int l15 = lane & 15, q = lane >> 4;
    __syncthreads();
#pragma unroll 4
    for (int i4 = tid; i4 < 2048 * 4; i4 += 512) { const int k = i4 >> 2, e0 = 4 * (i4 & 3); const f32x4 w = *(const f32x4*)(router_w + 4 * i4);
#pragma unroll
        for (int c = 0; c < 4; ++c) *(LAS bf16_t*)(lds + RT_W + (e0 + c) * RT_WRS + k * 2) = (bf16_t)f2bf(w[c]); }
    __syncthreads();
    const int ngroups = nrows / 16;
    u32x4 nxr[2][4];
    const int gb = (int)(((long)blockIdx.x * ngroups) / gridDim.x), ge = (int)(((long)(blockIdx.x + 1) * ngroups) / gridDim.x);
    f32x4 Am[4][2], Sm[4][2]; int mcur = -1;
    if (gb < ge) {
#pragma unroll
        for (int rr = 0; rr < 2; ++rr)
#pragma unroll
            for (int j = 0; j < 4; ++j) nxr[rr][j] = *(const u32x4*)(X1 + (size_t)(gb * 16 + 2 * wv + rr) * D + 8 * (lane + 64 * j)); }
    for (int grp = gb; grp < ge; ++grp) {
        u32x4 cxr[2][4];
#pragma unroll
        for (int rr = 0; rr < 2; ++rr)
#pragma unroll
            for (int j = 0; j < 4; ++j) cxr[rr][j] = nxr[rr][j];
        if (grp + 1 < ge) {
#pragma unroll
            for (int rr = 0; rr < 2; ++rr)
#pragma unroll
                for (int j = 0; j < 4; ++j) nxr[rr][j] = *(const u32x4*)(X1 + (size_t)((grp + 1) * 16 + 2 * wv + rr) * D + 8 * (lane + 64 * j)); }
        { const int mrow = (grp * 16) < M_LAT ? ((grp * 16) >> 12) : 4;
            if (mrow != mcur) { mcur = mrow; const float* mr = modl + (size_t)mrow * 12288;
#pragma unroll
                for (int j = 0; j < 4; ++j)
#pragma unroll
                    for (int t2 = 0; t2 < 2; ++t2) { const int k = 8 * (lane + 64 * j) + 4 * t2; Am[j][t2] = *(const f32x4*)(gain + k) * (*(const f32x4*)(mr + sc_off + k) + 1.f); Sm[j][t2] = *(const f32x4*)(mr + sh_off + k); } } }
#pragma unroll
        for (int rr = 0; rr < 2; ++rr) {
            const int lr = 2 * wv + rr, r = grp * 16 + lr;
            f32x4 v[4][2]; float ss = 0.f;
#pragma unroll
            for (int j = 0; j < 4; ++j) { const u32x4 w = cxr[rr][j];
                v[j][0] = (f32x4){bflo(w.x), bfhi(w.x), bflo(w.y), bfhi(w.y)}; v[j][1] = (f32x4){bflo(w.z), bfhi(w.z), bflo(w.w), bfhi(w.w)};
#pragma unroll
                for (int t2 = 0; t2 < 2; ++t2) ss += (v[j][t2][0] * v[j][t2][0] + v[j][t2][1] * v[j][t2][1]) + (v[j][t2][2] * v[j][t2][2] + v[j][t2][3] * v[j][t2][3]); }
            const float rstd = rsqrtf(wave_sum(ss) * (1.f / D) + EPS);
            bf16_t* orow = Hb + (size_t)r * D;
#pragma unroll
            for (int j = 0; j < 4; ++j) { const int k = 8 * (lane + 64 * j);
                f32x4 hv[2];
#pragma unroll
                for (int t2 = 0; t2 < 2; ++t2) hv[t2] = v[j][t2] * rstd * Am[j][t2] + Sm[j][t2];
                u32x4 w; w.x = pk2(hv[0][0], hv[0][1]); w.y = pk2(hv[0][2], hv[0][3]); w.z = pk2(hv[1][0], hv[1][1]); w.w = pk2(hv[1][2], hv[1][3]);
                *(u32x4*)(orow + k) = w; *(LAS u32x4*)(lds + RT_H + lr * RT_HRS + k * 2) = w; }
        }
        lds_barrier();
        f32x4 acc = (f32x4){0.f, 0.f, 0.f, 0.f};
#pragma unroll
        for (int kk = 0; kk < 8; ++kk) { const int kb = (256 * wv + 32 * kk + 8 * q) * 2;
            const bf16x8 af = *(const LAS bf16x8*)(lds + RT_H + l15 * RT_HRS + kb), bfr = *(const LAS bf16x8*)(lds + RT_W + l15 * RT_WRS + kb);
            acc = __builtin_amdgcn_mfma_f32_16x16x32_bf16(af, bfr, acc, 0, 0, 0); }
        { LAS float* red = (LAS float*)(lds + RT_RED) + wv * 256;
#pragma unroll
            for (int rg = 0; rg < 4; ++rg) red[(4 * q + rg) * 16 + l15] = acc[rg]; }
        lds_barrier();
        if (tid < 256) { const int row = tid >> 4, e = tid & 15; float lg = 0.f;
#pragma unroll
            for (int w = 0; w < 8; ++w) lg += ((const LAS float*)(lds + RT_RED))[w * 256 + tid];
            float mx = lg;
#pragma unroll
            for (int o = 1; o < 16; o <<= 1) mx = fmaxf(mx, __shfl_xor(mx, o));
            const float ex = __expf(lg - mx); float den = ex;
#pragma unroll
            for (int o = 1; o < 16; o <<= 1) den += __shfl_xor(den, o);
            const float p = ex / den; const int r = grp * 16 + row;
            if (r < M_LAT) aff[((size_t)((r >> 12) * NE + e)) * T + (r & 4095)] = p;
            else { const int rc = r - M_LAT; aff[(size_t)NB * NE * T + ((size_t)((rc >> 8) * NE + e)) * CL + (rc & 255)] = p; } }
        lds_barrier();
    }
}

__device__ __forceinline__ int block_excl_scan(int v, LAS int* wsum, int lane, int wave, int& total) {
    int incl = v;
#pragma unroll
    for (int o = 1; o < 64; o <<= 1) { const int t = __shfl_up(incl, o); if (lane >= o) incl += t; }
    __syncthreads();
    if (lane == 63) wsum[wave] = incl;
    __syncthreads();
    int base = 0, tot = 0;
#pragma unroll
    for (int w = 0; w < 8; ++w) { const int s = wsum[w]; tot += s; base += (w < wave) ? s : 0; }
    total = tot;
    return base + incl - v;
}
__device__ __forceinline__ void phase_topk(const float* aff, int* SRC, float* GATE, int* INV, int RPE, bool with_ctx, LAS unsigned char* lds) {
    const int tid = threadIdx.x, lane = tid & 63, wave = tid >> 6;
    LAS int* wsum = (LAS int*)lds;
    LAS int* cnts = (LAS int*)(lds + 64);
    const int nunits = with_ctx ? 128 : 64;
    for (int u = blockIdx.x; u < nunits; u += gridDim.x) {
        const int kind = u >> 6, b = (u >> 4) & 3, e = u & 15;
        const int Tn = kind ? CL : T, cap = Tn / 8;
        const float* av = aff + (kind ? (size_t)NB * NE * T + (size_t)(b * NE + e) * CL : (size_t)(b * NE + e) * T);
        unsigned vb[8];
#pragma unroll
        for (int j = 0; j < 8; ++j) { const int t = tid * 8 + j; vb[j] = t < Tn ? __float_as_uint(av[t]) : 0u; }
        unsigned thr = 0u;
        for (int bit = 30; bit >= 0; --bit) {
            const unsigned cand = thr | (1u << bit);
            int c = 0;
#pragma unroll
            for (int j = 0; j < 8; ++j) c += (vb[j] >= cand) ? 1 : 0;
#pragma unroll
            for (int o = 1; o < 64; o <<= 1) c += __shfl_xor(c, o);
            LAS int* cb = cnts + (bit & 1) * 8;
            if (lane == 0) cb[wave] = c;
            __syncthreads();
            int tot = 0;
#pragma unroll
            for (int w = 0; w < 8; ++w) tot += cb[w];
            if (tot >= cap) thr = cand;
        }
        int ngt_l = 0, neq_l = 0;
#pragma unroll
        for (int j = 0; j < 8; ++j) { ngt_l += (vb[j] > thr) ? 1 : 0; neq_l += (vb[j] == thr) ? 1 : 0; }
        int ngt_tot, neq_tot;
        (void)block_excl_scan(ngt_l, wsum, lane, wave, ngt_tot);
        const int eq_base = block_excl_scan(neq_l, wsum, lane, wave, neq_tot);
        const int need_eq = cap - ngt_tot;
        int sel_l = 0, eqr = eq_base; unsigned selmask = 0u;
#pragma unroll
        for (int j = 0; j < 8; ++j) { bool s = vb[j] > thr; if (vb[j] == thr) { s = eqr < need_eq; ++eqr; } if (vb[j] == 0u) s = false; selmask |= s ? (1u << j) : 0u; sel_l += s ? 1 : 0; }
        int sel_tot;
        int slot = block_excl_scan(sel_l, wsum, lane, wave, sel_tot);
        const int gbase = e * RPE + (kind ? 2048 + b * 32 : b * 512);
        const int rbase = kind ? M_LAT + b * CL : b * T;
#pragma unroll
        for (int j = 0; j < 8; ++j) { const int t = tid * 8 + j;
            if (t < Tn) { int g = -1;
                if (selmask & (1u << j)) { g = gbase + slot; ++slot; SRC[g] = rbase + t; GATE[g] = __uint_as_float(vb[j]); }
                INV[(size_t)(rbase + t) * NE + e] = g; } }
        if (kind == 1 && b == 0 && tid < 128) { SRC[e * RPE + 2176 + tid] = 0; GATE[e * RPE + 2176 + tid] = 0.f; }
        __syncthreads();
    }
}

template <bool LAST>
__device__ __forceinline__ void phase_moe_combine(bf16_t* X1, const bf16_t* Ye, const int* INV, const float* GATE, const float* g2  , int nrows,
                                                  const float* gain, const float* modn, bf16_t* Hb, float* out) {
    const int lane = threadIdx.x & 63, wave = threadIdx.x >> 6;
    const int gw = blockIdx.x * 8 + wave, NGW = gridDim.x * 8;
    u32x4 inv[4], nx[4];
    if (gw < nrows) {
#pragma unroll
        for (int i = 0; i < 4; ++i) { inv[i] = *(const u32x4*)(INV + (size_t)gw * NE + 4 * i); nx[i] = *(const u32x4*)(X1 + (size_t)gw * D + 8 * (lane + 64 * i)); } }
    for (int r = gw; r < nrows; r += NGW) {
        const int mrow = r < M_LAT ? (r >> 12) : 4;
        const unsigned sl[16] = {inv[0].x, inv[0].y, inv[0].z, inv[0].w, inv[1].x, inv[1].y, inv[1].z, inv[1].w, inv[2].x, inv[2].y, inv[2].z, inv[2].w, inv[3].x, inv[3].y, inv[3].z, inv[3].w};
        if (r + NGW < nrows) {
#pragma unroll
            for (int i = 0; i < 4; ++i) inv[i] = *(const u32x4*)(INV + (size_t)(r + NGW) * NE + 4 * i); }
        f32x4 acc[4][2];
#pragma unroll
        for (int j = 0; j < 4; ++j) { acc[j][0] = (f32x4){0.f, 0.f, 0.f, 0.f}; acc[j][1] = (f32x4){0.f, 0.f, 0.f, 0.f}; }
#pragma unroll
        for (int e = 0; e < NE; ++e) {
            const int s = __builtin_amdgcn_readfirstlane((int)sl[e]);
            if (s >= 0) { const float gt = GATE[s]; const bf16_t* yr = Ye + (size_t)s * D;
#pragma unroll
                for (int j = 0; j < 4; ++j) { const u32x4 w = *(const u32x4*)(yr + 8 * (lane + 64 * j));
                    acc[j][0] += (f32x4){bflo(w.x), bfhi(w.x), bflo(w.y), bfhi(w.y)} * gt; acc[j][1] += (f32x4){bflo(w.z), bfhi(w.z), bflo(w.w), bfhi(w.w)} * gt; } }
        }
        bf16_t* xr = X1 + (size_t)r * D; const float* gr = g2 + (size_t)mrow * 12288;
        u32x4 xw_[4];
#pragma unroll
        for (int j = 0; j < 4; ++j) xw_[j] = nx[j];
        if (r + NGW < nrows) {
#pragma unroll
            for (int j = 0; j < 4; ++j) nx[j] = *(const u32x4*)(X1 + (size_t)(r + NGW) * D + 8 * (lane + 64 * j)); }
        f32x4 v[4][2]; float ss = 0.f;
#pragma unroll
        for (int j = 0; j < 4; ++j) { const int k = 8 * (lane + 64 * j); const u32x4 w = xw_[j];
            v[j][0] = (f32x4){bflo(w.x), bfhi(w.x), bflo(w.y), bfhi(w.y)} + *(const f32x4*)(gr + k) * acc[j][0];
            v[j][1] = (f32x4){bflo(w.z), bfhi(w.z), bflo(w.w), bfhi(w.w)} + *(const f32x4*)(gr + k + 4) * acc[j][1];
#pragma unroll
            for (int t2 = 0; t2 < 2; ++t2) ss += (v[j][t2][0] * v[j][t2][0] + v[j][t2][1] * v[j][t2][1]) + (v[j][t2][2] * v[j][t2][2] + v[j][t2][3] * v[j][t2][3]); }
        const float rstd = rsqrtf(wave_sum(ss) * (1.f / D) + EPS);
        if (LAST) {
#pragma unroll
            for (int j = 0; j < 4; ++j) { const int k = 8 * (lane + 64 * j);
                *(f32x4*)(out + (size_t)r * D + k) = v[j][0] * rstd * *(const f32x4*)(gain + k); *(f32x4*)(out + (size_t)r * D + k + 4) = v[j][1] * rstd * *(const f32x4*)(gain + k + 4); }
        } else {
            const float* mr = modn + (size_t)mrow * 12288;
#pragma unroll
            for (int j = 0; j < 4; ++j) { const int k = 8 * (lane + 64 * j);
                u32x4 xw; xw.x = pk2(v[j][0][0], v[j][0][1]); xw.y = pk2(v[j][0][2], v[j][0][3]); xw.z = pk2(v[j][1][0], v[j][1][1]); xw.w = pk2(v[j][1][2], v[j][1][3]);
                *(u32x4*)(xr + k) = xw;
                f32x4 h[2];
#pragma unroll
                for (int t2 = 0; t2 < 2; ++t2) h[t2] = v[j][t2] * rstd * *(const f32x4*)(gain + k + 4 * t2) * (*(const f32x4*)(mr + D + k + 4 * t2) + 1.f) + *(const f32x4*)(mr + k + 4 * t2);
                u32x4 w; w.x = pk2(h[0][0], h[0][1]); w.y = pk2(h[0][2], h[0][3]); w.z = pk2(h[1][0], h[1][1]); w.w = pk2(h[1][2], h[1][3]);
                *(u32x4*)(Hb + (size_t)r * D + k) = w; }
        }
    }
}

__device__ __forceinline__ void phase_head_combine_bf16(const bf16_t* Of, const bf16_t* Ob, const bf16_t* P, int ldp, int gcol, const float* gain, bf16_t* AO, int ocol, int nrows) {
    const int lane = threadIdx.x & 63, wave = threadIdx.x >> 6;
    const int gw = blockIdx.x * 8 + wave, NGW = gridDim.x * 8;
    const int hc = (lane >> 3) * 128 + (lane & 7) * 16;
    u32x4 nf0, nf1, nb0, nb1, ng0, ng1;
#define HC_LOAD(rr) do { const u32x4* pf_ = (const u32x4*)(Of + (size_t)(rr) * 1024 + hc); const u32x4* pb_ = (const u32x4*)(Ob + (size_t)(rr) * 1024 + hc); const u32x4* gp_ = (const u32x4*)(P + (size_t)(rr) * ldp + gcol + hc); \
        nf0 = pf_[0]; nf1 = pf_[1]; nb0 = pb_[0]; nb1 = pb_[1]; ng0 = gp_[0]; ng1 = gp_[1]; } while (0)
    f32x4 gnv[4];
#pragma unroll
    for (int i = 0; i < 4; ++i) gnv[i] = *(const f32x4*)(gain + hc + 4 * i);
    if (gw < nrows) HC_LOAD(gw);
    for (int r = gw; r < nrows; r += NGW) {
        const unsigned fw[8] = {nf0.x, nf0.y, nf0.z, nf0.w, nf1.x, nf1.y, nf1.z, nf1.w}, bw[8] = {nb0.x, nb0.y, nb0.z, nb0.w, nb1.x, nb1.y, nb1.z, nb1.w};
        const unsigned gw_[8] = {ng0.x, ng0.y, ng0.z, ng0.w, ng1.x, ng1.y, ng1.z, ng1.w};
        if (r + NGW < nrows) HC_LOAD(r + NGW);
        f32x4 o[4]; float ss = 0.f;
#pragma unroll
        for (int i = 0; i < 4; ++i) { o[i] = (f32x4){bflo(fw[2 * i]) + bflo(bw[2 * i]), bfhi(fw[2 * i]) + bfhi(bw[2 * i]), bflo(fw[2 * i + 1]) + bflo(bw[2 * i + 1]), bfhi(fw[2 * i + 1]) + bfhi(bw[2 * i + 1])};
            ss += (o[i][0] * o[i][0] + o[i][1] * o[i][1]) + (o[i][2] * o[i][2] + o[i][3] * o[i][3]); }
        ss += __shfl_xor(ss, 1); ss += __shfl_xor(ss, 2); ss += __shfl_xor(ss, 4);
        const float rstd = rsqrtf(ss * (1.f / 128.f) + EPS);
        unsigned ow[8];
#pragma unroll
        for (int i = 0; i < 4; ++i) { const f32x4 gn = gnv[i];
            const float a0 = o[i][0] * rstd * gn[0] * silu_f(bflo(gw_[2 * i])), a1 = o[i][1] * rstd * gn[1] * silu_f(bfhi(gw_[2 * i]));
            const float a2 = o[i][2] * rstd * gn[2] * silu_f(bflo(gw_[2 * i + 1])), a3 = o[i][3] * rstd * gn[3] * silu_f(bfhi(gw_[2 * i + 1]));
            ow[2 * i] = pk2(a0, a1); ow[2 * i + 1] = pk2(a2, a3); }
        u32x4* op = (u32x4*)(AO + (size_t)r * D + ocol + hc);
        op[0] = (u32x4){ow[0], ow[1], ow[2], ow[3]}; op[1] = (u32x4){ow[4], ow[5], ow[6], ow[7]};
    }
#undef HC_LOAD
}

__device__ __forceinline__ bf16x8 tr_frag(LAS unsigned char* p0, int hi_off) {
    const s16x4 lo = __builtin_amdgcn_ds_read_tr16_b64_v4i16((LAS s16x4*)p0);
    const s16x4 hi = __builtin_amdgcn_ds_read_tr16_b64_v4i16((LAS s16x4*)(p0 + hi_off));
    return (bf16x8){lo[0], lo[1], lo[2], lo[3], hi[0], hi[1], hi[2], hi[3]};
}
constexpr int R_RS = 288;
constexpr int RP_KS = 0, RP_V1 = 128 * R_RS, RP_V2 = 2 * 128 * R_RS, RP_ROT = 3 * 128 * R_RS;
static_assert(RP_ROT + 16384 <= LDS_BARW, "parallel retention LDS map");
constexpr int NRC = (CL + T) / 128;
__device__ __forceinline__ int retp_row(int b, int sp) { return sp < CL ? M_LAT + b * CL + sp : b * T + (sp - CL); }
__device__ __forceinline__ void retp_stage_k(const bf16_t* P, int b, int h, int j, LAS unsigned char* lds) {
    const int tid = threadIdx.x;
#pragma unroll
    for (int i = 0; i < 2; ++i) { const int task = tid + 512 * i, p = task >> 3, sec = (task >> 2) & 1, fg = task & 3;
        const int sp = j * 128 + p;
        const bf16_t* pr = P + (size_t)retp_row(b, sp) * LDP0 + 4096 + h * 128 + sec * 64 + 8 * fg;
        const u32x4 r1 = *(const u32x4*)pr, r2 = *(const u32x4*)(pr + 32);
        f32x4 c0 = (f32x4){1.f, 1.f, 1.f, 1.f}, c1 = c0, s0 = (f32x4){0.f, 0.f, 0.f, 0.f}, s1 = s0;
        if (sp >= CL) { const int t = sp - CL; const int pos = sec ? (t & 63) : (t >> 6);
            const LAS f32x4* cp = (const LAS f32x4*)(lds + RP_ROT + (pos * 32 + 8 * fg) * 4); const LAS f32x4* spp = (const LAS f32x4*)(lds + RP_ROT + 8192 + (pos * 32 + 8 * fg) * 4);
            c0 = cp[0]; c1 = cp[1]; s0 = spp[0]; s1 = spp[1]; }
        const float cc[8] = {c0[0], c0[1], c0[2], c0[3], c1[0], c1[1], c1[2], c1[3]}, ss[8] = {s0[0], s0[1], s0[2], s0[3], s1[0], s1[1], s1[2], s1[3]};
        const unsigned k1w[4] = {r1.x, r1.y, r1.z, r1.w}, k2w[4] = {r2.x, r2.y, r2.z, r2.w};
        unsigned o1[4], o2[4];
#pragma unroll
        for (int w = 0; w < 4; ++w) { const float ka0 = bflo(k1w[w]), ka1 = bfhi(k1w[w]), kb0 = bflo(k2w[w]), kb1 = bfhi(k2w[w]);
            const float ce = cc[2 * w], co = cc[2 * w + 1], se = ss[2 * w], so = ss[2 * w + 1];
            o1[w] = pk2(ka0 * ce - kb0 * se, ka1 * co - kb1 * so); o2[w] = pk2(ka0 * se + kb0 * ce, ka1 * so + kb1 * co); }
        const int off = p * R_RS + (sec * 64 + 8 * fg) * 2;
        *(LAS u32x4*)(lds + RP_KS + off) = (u32x4){o1[0], o1[1], o1[2], o1[3]}; *(LAS u32x4*)(lds + RP_KS + off + 64) = (u32x4){o2[0], o2[1], o2[2], o2[3]}; }
}
__device__ __forceinline__ void retp_kv_unit(int unit, const bf16_t* P, const float* rotg, const float* gamma_logit, bf16_t* KVT, LAS unsigned char* lds) {
    const int tid = threadIdx.x, lane = tid & 63, wv = __builtin_amdgcn_readfirstlane(tid >> 6);
    const int j = unit % NRC, h = (unit / NRC) & 7, b = unit / (NRC * 8);
    const int l15 = lane & 15, q = lane >> 4, trq = l15 >> 2, trp = lane & 3;
    const float lgf = -log1pf(expf(-gamma_logit[h])) * 1.4426950408889634f, lgb = -log1pf(expf(-gamma_logit[8 + h])) * 1.4426950408889634f;
    __syncthreads();
    retp_stage_k(P, b, h, j, lds);
#pragma unroll
    for (int i = 0; i < 4; ++i) { const int piece = tid + 512 * i, p = piece >> 4, ch = piece & 15;
        const u32x4 v = *(const u32x4*)(P + (size_t)retp_row(b, j * 128 + p) * LDP0 + 5120 + h * 128 + 8 * ch); const unsigned vw[4] = {v.x, v.y, v.z, v.w};
        const float sf = exp2f(lgf * (float)(127 - p)), sb = exp2f(lgb * (float)p);
        unsigned of[4], ob[4];
#pragma unroll
        for (int w = 0; w < 4; ++w) { of[w] = pk2(bflo(vw[w]) * sf, bfhi(vw[w]) * sf); ob[w] = pk2(bflo(vw[w]) * sb, bfhi(vw[w]) * sb); }
        *(LAS u32x4*)(lds + RP_V1 + p * R_RS + ch * 16) = (u32x4){of[0], of[1], of[2], of[3]}; *(LAS u32x4*)(lds + RP_V2 + p * R_RS + ch * 16) = (u32x4){ob[0], ob[1], ob[2], ob[3]}; }
    __syncthreads();
    f32x4 acc[2][8];
#pragma unroll
    for (int d = 0; d < 2; ++d)
#pragma unroll
        for (int c = 0; c < 8; ++c) acc[d][c] = (f32x4){0.f, 0.f, 0.f, 0.f};
#pragma unroll
    for (int kk = 0; kk < 4; ++kk) { const bf16x8 ktf = tr_frag(lds + RP_KS + (32 * kk + 8 * q + trq) * R_RS + (16 * wv + 4 * trp) * 2, 4 * R_RS);
#pragma unroll
        for (int c = 0; c < 8; ++c) { const bf16x8 v1 = tr_frag(lds + RP_V1 + (32 * kk + 8 * q + trq) * R_RS + (16 * c + 4 * trp) * 2, 4 * R_RS), v2 = tr_frag(lds + RP_V2 + (32 * kk + 8 * q + trq) * R_RS + (16 * c + 4 * trp) * 2, 4 * R_RS);
            acc[0][c] = __builtin_amdgcn_mfma_f32_16x16x32_bf16(ktf, v1, acc[0][c], 0, 0, 0); acc[1][c] = __builtin_amdgcn_mfma_f32_16x16x32_bf16(ktf, v2, acc[1][c], 0, 0, 0); } }
    const int nb = j < 2 ? 1 - j : 35 - j;
#pragma unroll
    for (int d = 0; d < 2; ++d) { bf16_t* dst = KVT + ((size_t)(((b * 8 + h) * 2 + d) * NRC + (d ? nb : j))) * 16384 + (size_t)l15 * 128 + 16 * wv + 4 * q;
#pragma unroll
        for (int c = 0; c < 8; ++c) { u32x2 w; w.x = pk2(acc[d][c][0], acc[d][c][1]); w.y = pk2(acc[d][c][2], acc[d][c][3]); *(u32x2*)(dst + (size_t)(16 * c) * 128) = w; } }
}
__device__ __forceinline__ void retp_scan_unit(int unit, const float* gamma_logit, const bf16_t* KVT, bf16_t* ST) {
    const int tid = threadIdx.x;
    const int bhd = unit >> 2, qtr = unit & 3, d = bhd & 1, h = (bhd >> 1) & 7;
    const float g128 = exp2f(-log1pf(expf(-gamma_logit[d * 8 + h])) * 1.4426950408889634f * 128.f);
    const u32x4* src = (const u32x4*)(KVT + (size_t)bhd * NRC * 16384) + qtr * 512 + tid; u32x4* dst = (u32x4*)(ST + (size_t)bhd * NRC * 16384) + qtr * 512 + tid;
    u32x4 kv[NRC];
#pragma unroll
    for (int n = 0; n < NRC; ++n) kv[n] = src[(size_t)n * 2048];
    float st[8];
#pragma unroll
    for (int k = 0; k < 8; ++k) st[k] = 0.f;
#pragma unroll
    for (int n = 0; n < NRC; ++n) {
        dst[(size_t)n * 2048] = (u32x4){pk2(st[0], st[1]), pk2(st[2], st[3]), pk2(st[4], st[5]), pk2(st[6], st[7])};
        const unsigned w[4] = {kv[n].x, kv[n].y, kv[n].z, kv[n].w};
#pragma unroll
        for (int k = 0; k < 4; ++k) { st[2 * k] = g128 * st[2 * k] + bflo(w[k]); st[2 * k + 1] = g128 * st[2 * k + 1] + bfhi(w[k]); }
    }
}
__device__ __forceinline__ void retp_out_unit(int unit, const bf16_t* P, const float* rotg, const float* gamma_logit, const bf16_t* ST, const float* gain, bf16_t* AO, LAS unsigned char* lds) {
    const int tid = threadIdx.x, lane = tid & 63, wv = __builtin_amdgcn_readfirstlane(tid >> 6);
    const int j = unit % NRC, h = (unit / NRC) & 7, b = unit / (NRC * 8);
    const int l15 = lane & 15, q = lane >> 4, trq = l15 >> 2, trp = lane & 3;
    const float lgf = -log1pf(expf(-gamma_logit[h])) * 1.4426950408889634f, lgb = -log1pf(expf(-gamma_logit[8 + h])) * 1.4426950408889634f;
    const float qscale = 0.08838834764831845f;
    __syncthreads();
    const int nbk = j < 2 ? 1 - j : 35 - j;
    const bf16_t* sF = ST + ((size_t)(((b * 8 + h) * 2 + 0) * NRC + j)) * 16384; const bf16_t* sB = ST + ((size_t)(((b * 8 + h) * 2 + 1) * NRC + nbk)) * 16384;
    u32x4 vr[4], sfr[4], sbr[4], gtr[4];
#pragma unroll
    for (int i = 0; i < 4; ++i) { const int piece = tid + 512 * i, p = piece >> 4, ch = piece & 15; const bf16_t* prow = P + (size_t)retp_row(b, j * 128 + p) * LDP0 + h * 128 + 8 * ch;
        vr[i] = *(const u32x4*)(prow + 5120); gtr[i] = *(const u32x4*)(prow + 1024); sfr[i] = *(const u32x4*)(sF + (size_t)piece * 8); sbr[i] = *(const u32x4*)(sB + (size_t)piece * 8); }
    __builtin_amdgcn_sched_barrier(0);
    retp_stage_k(P, b, h, j, lds);
#pragma unroll
    for (int i = 0; i < 4; ++i) { const int piece = tid + 512 * i, p = piece >> 4, ch = piece & 15;
        *(LAS u32x4*)(lds + RP_V1 + p * R_RS + ch * 16) = vr[i]; *(LAS u32x4*)(lds + RP_V2 + p * R_RS + ch * 16) = sfr[i]; }
    const int tl = 16 * wv + l15, sp = j * 128 + tl, row = retp_row(b, sp);
    bf16x8 qf[4];
    { const bf16_t* qp = P + (size_t)row * LDP0 + h * 128 + 8 * q;
        u32x4 raw[4];
#pragma unroll
        for (int kk = 0; kk < 4; ++kk) raw[kk] = *(const u32x4*)(qp + 32 * kk);
#pragma unroll
        for (int sec = 0; sec < 2; ++sec) { f32x4 c0 = (f32x4){1.f, 1.f, 1.f, 1.f}, c1 = c0, s0 = (f32x4){0.f, 0.f, 0.f, 0.f}, s1 = s0;
            if (sp >= CL) { const int t = sp - CL; const int pos = sec ? (t & 63) : (t >> 6);
                const LAS f32x4* cp = (const LAS f32x4*)(lds + RP_ROT + (pos * 32 + 8 * q) * 4); const LAS f32x4* spp = (const LAS f32x4*)(lds + RP_ROT + 8192 + (pos * 32 + 8 * q) * 4);
                c0 = cp[0]; c1 = cp[1]; s0 = spp[0]; s1 = spp[1]; }
            const float cc[8] = {c0[0], c0[1], c0[2], c0[3], c1[0], c1[1], c1[2], c1[3]}, ss[8] = {s0[0], s0[1], s0[2], s0[3], s1[0], s1[1], s1[2], s1[3]};
            const unsigned a1[4] = {raw[2 * sec].x, raw[2 * sec].y, raw[2 * sec].z, raw[2 * sec].w}, a2[4] = {raw[2 * sec + 1].x, raw[2 * sec + 1].y, raw[2 * sec + 1].z, raw[2 * sec + 1].w};
            unsigned o1[4], o2[4];
#pragma unroll
            for (int w = 0; w < 4; ++w) { const float qa0 = bflo(a1[w]) * qscale, qa1 = bfhi(a1[w]) * qscale, qb0 = bflo(a2[w]) * qscale, qb1 = bfhi(a2[w]) * qscale;
                const float ce = cc[2 * w], co = cc[2 * w + 1], se = ss[2 * w], so = ss[2 * w + 1];
                o1[w] = pk2(qa0 * ce - qb0 * se, qa1 * co - qb1 * so); o2[w] = pk2(qa0 * se + qb0 * ce, qa1 * so + qb1 * co); }
            qf[2 * sec] = __builtin_bit_cast(bf16x8, (u32x4){o1[0], o1[1], o1[2], o1[3]}); qf[2 * sec + 1] = __builtin_bit_cast(bf16x8, (u32x4){o2[0], o2[1], o2[2], o2[3]}); } }
    const float fa = exp2f(lgf * (float)l15), ba = exp2f(-lgb * (float)l15);
    float fbq[4], bbq[4];
#pragma unroll
    for (int r = 0; r < 4; ++r) { fbq[r] = exp2f(-lgf * (float)(4 * q + r)); bbq[r] = exp2f(lgb * (float)(4 * q + r)); }
    __syncthreads();
    f32x4 acc[8];
#pragma unroll
    for (int c = 0; c < 8; ++c) acc[c] = (f32x4){0.f, 0.f, 0.f, 0.f};
#pragma unroll
    for (int m = 0; m < 4; ++m) {
        unsigned pk[4];
#pragma unroll
        for (int hf = 0; hf < 2; ++hf) { const int st = 2 * m + hf;
            f32x4 X = (f32x4){0.f, 0.f, 0.f, 0.f};
#pragma unroll
            for (int kk = 0; kk < 4; ++kk) { const bf16x8 kf = *(const LAS bf16x8*)(lds + RP_KS + (16 * st + l15) * R_RS + (32 * kk + 8 * q) * 2); X = __builtin_amdgcn_mfma_f32_16x16x32_bf16(kf, qf[kk], X, 0, 0, 0); }
            float f[4];
            if (st < wv) { const float cf = exp2f(lgf * (float)(16 * (wv - st))) * fa;
#pragma unroll
                for (int r = 0; r < 4; ++r) f[r] = cf * fbq[r]; }
            else if (st > wv) { const float cb = exp2f(lgb * (float)(16 * (st - wv))) * ba;
#pragma unroll
                for (int r = 0; r < 4; ++r) f[r] = cb * bbq[r]; }
            else {
#pragma unroll
                for (int r = 0; r < 4; ++r) { const int sl = 4 * q + r; f[r] = sl < l15 ? fa * fbq[r] : (sl > l15 ? ba * bbq[r] : 2.f); } }
            pk[2 * hf] = pk2(X[0] * f[0], X[1] * f[1]); pk[2 * hf + 1] = pk2(X[2] * f[2], X[3] * f[3]); }
        const bf16x8 pa = __builtin_bit_cast(bf16x8, (u32x4){pk[0], pk[1], pk[2], pk[3]});
#pragma unroll
        for (int c = 0; c < 8; ++c) { const bf16x8 vf = tr_frag(lds + RP_V1 + (32 * m + 4 * q + trq) * R_RS + (16 * c + 4 * trp) * 2, 16 * R_RS);
            acc[c] = __builtin_amdgcn_mfma_f32_16x16x32_bf16(vf, pa, acc[c], 0, 0, 0); }
    }
#pragma unroll
    for (int d = 0; d < 2; ++d) {
        if (d == 1) { lds_barrier();
#pragma unroll
            for (int i = 0; i < 4; ++i) { const int piece = tid + 512 * i, p = piece >> 4, ch = piece & 15;
                *(LAS u32x4*)(lds + RP_KS + p * R_RS + ch * 16) = sbr[i]; *(LAS u32x4*)(lds + RP_V1 + p * R_RS + ch * 16) = gtr[i]; }
            lds_barrier(); }
        const LAS unsigned char* sb = lds + (d ? RP_KS : RP_V2) + l15 * R_RS + (8 * q) * 2;
        f32x4 t2[8];
#pragma unroll
        for (int c = 0; c < 8; ++c) t2[c] = (f32x4){0.f, 0.f, 0.f, 0.f};
#pragma unroll
        for (int kk = 0; kk < 4; ++kk)
#pragma unroll
            for (int c = 0; c < 8; ++c) { const bf16x8 sf = *(const LAS bf16x8*)(sb + (16 * c) * R_RS + 64 * kk); t2[c] = __builtin_amdgcn_mfma_f32_16x16x32_bf16(sf, qf[kk], t2[c], 0, 0, 0); }
        const float sc = d ? exp2f(lgb * (float)(128 - tl)) : exp2f(lgf * (float)(tl + 1));
#pragma unroll
        for (int c = 0; c < 8; ++c) acc[c] += t2[c] * sc;
    }
    float ss = 0.f;
#pragma unroll
    for (int c = 0; c < 8; ++c) ss += (acc[c][0] * acc[c][0] + acc[c][1] * acc[c][1]) + (acc[c][2] * acc[c][2] + acc[c][3] * acc[c][3]);
    ss += __shfl_xor(ss, 16); ss += __shfl_xor(ss, 32);
    const float rstd = rsqrtf(ss * (1.f / 128.f) + EPS);
    const LAS unsigned char* gp = lds + RP_V1 + tl * R_RS + (4 * q) * 2; bf16_t* op = AO + (size_t)row * D + h * 128 + 4 * q; const float* gn = gain + h * 128 + 4 * q;
#pragma unroll
    for (int c = 0; c < 8; ++c) { const u32x2 gw = *(const LAS u32x2*)(gp + 32 * c); const f32x4 g4 = *(const f32x4*)(gn + 16 * c);
        u32x2 o; o.x = pk2(acc[c][0] * rstd * g4[0] * silu_f(bflo(gw.x)), acc[c][1] * rstd * g4[1] * silu_f(bfhi(gw.x)));
        o.y = pk2(acc[c][2] * rstd * g4[2] * silu_f(bflo(gw.y)), acc[c][3] * rstd * g4[3] * silu_f(bfhi(gw.y)));
        *(u32x2*)(op + 16 * c) = o; }
}

constexpr int G_RS = 160, G_RSV = 288;
constexpr int G_QS = 0, G_KS = 64 * G_RS, G_KP = 2 * 64 * G_RS, G_VS = 3 * 64 * G_RS, G_ST = G_VS + 64 * G_RSV, G_SEG = G_ST + 128 * G_RS, G_BEND = G_SEG + 8 * 64 * 4, G_END = G_BEND + 256;
__device__ __forceinline__ int gla_lowrow(int b, int dir, int sp0) { return sp0 < CL ? M_LAT + b * CL + (dir ? CL - 64 - sp0 : sp0) : b * T + (dir ? T - 64 - (sp0 - CL) : sp0 - CL); }
__device__ __forceinline__ int gla_row(int b, int dir, int sp) { return sp < CL ? M_LAT + b * CL + (dir ? CL - 1 - sp : sp) : b * T + (dir ? T - 1 - (sp - CL) : sp - CL); }
__device__ __forceinline__ void gla_fast_unit(int unit, const bf16_t* P, const float* w_up, const float* b_up, float* Of, float* Ob, LAS unsigned char* lds0) {
    const int tid = threadIdx.x, lane = tid & 63, wv = __builtin_amdgcn_readfirstlane(tid >> 6);
    const int dir = unit & 1, h = (unit >> 1) & 7, b = unit >> 4;
    const int l15 = lane & 15, q = lane >> 4, trq = l15 >> 2, trp = lane & 3;
    float* O = dir ? Ob : Of;
    constexpr int NCH = (CL + T) / 64;
    static_assert(2 * G_END <= LDS_BARW, "GLA double buffer");
    __syncthreads();
    if (wv < 4) {
        const int mw = wv;
        const unsigned ooff = (unsigned)((dir ? 63 - l15 : l15) * 2048 + (h * 128 + 32 * mw + 4 * q) * 2);
        f32x4 S[4][2];
#pragma unroll
        for (int dt = 0; dt < 4; ++dt) { S[dt][0] = (f32x4){0.f, 0.f, 0.f, 0.f}; S[dt][1] = (f32x4){0.f, 0.f, 0.f, 0.f}; }
        for (int cidx = -1; cidx < NCH + 1; ++cidx) {
            LAS unsigned char* lds = lds0 + (cidx & 1) * G_END;
            lds_barrier();
            if (cidx >= CL / 64 && cidx < NCH) {
                bf16x8 sfr[2][2];
#pragma unroll
                for (int kk = 0; kk < 2; ++kk)
#pragma unroll
                    for (int et = 0; et < 2; ++et) { const u32x4 w = (u32x4){pk2(S[2 * kk][et][0], S[2 * kk][et][1]), pk2(S[2 * kk][et][2], S[2 * kk][et][3]), pk2(S[2 * kk + 1][et][0], S[2 * kk + 1][et][1]), pk2(S[2 * kk + 1][et][2], S[2 * kk + 1][et][3])};
                        sfr[kk][et] = __builtin_bit_cast(bf16x8, w); }
                bf16x8 kf[4][2];
#pragma unroll
                for (int st = 0; st < 4; ++st)
#pragma unroll
                    for (int kk = 0; kk < 2; ++kk) { const LAS unsigned char* kp = lds + G_KS + (16 * st + l15) * G_RS + (32 * kk + 4 * q) * 2;
                        const u32x2 a0 = *(const LAS u32x2*)kp, a1 = *(const LAS u32x2*)(kp + 32); kf[st][kk] = __builtin_bit_cast(bf16x8, (u32x4){a0.x, a0.y, a1.x, a1.y}); }
                bf16x8 vfo[2][2];
#pragma unroll
                for (int m = 0; m < 2; ++m)
#pragma unroll
                    for (int et = 0; et < 2; ++et) vfo[m][et] = tr_frag(lds + G_VS + (32 * m + 4 * q + trq) * G_RSV + (32 * mw + 16 * et + 4 * trp) * 2, 16 * G_RSV);
#pragma unroll
                for (int sg = 0; sg < 4; ++sg) {
                    bf16x8 qf[2];
#pragma unroll
                    for (int kk = 0; kk < 2; ++kk) { const LAS unsigned char* qp = lds + G_QS + (16 * sg + l15) * G_RS + (32 * kk + 4 * q) * 2;
                        const u32x2 a0 = *(const LAS u32x2*)qp, a1 = *(const LAS u32x2*)(qp + 32); qf[kk] = __builtin_bit_cast(bf16x8, (u32x4){a0.x, a0.y, a1.x, a1.y}); }
                    f32x4 accO[2] = {(f32x4){0.f, 0.f, 0.f, 0.f}, (f32x4){0.f, 0.f, 0.f, 0.f}};
#pragma unroll
                    for (int kk = 0; kk < 2; ++kk)
#pragma unroll
                        for (int et = 0; et < 2; ++et) accO[et] = __builtin_amdgcn_mfma_f32_16x16x32_bf16(sfr[kk][et], qf[kk], accO[et], 0, 0, 0);
#pragma unroll
                    for (int m = 0; m <= (sg >> 1); ++m) {
                        unsigned pk[4];
#pragma unroll
                        for (int hf = 0; hf < 2; ++hf) { const int st = 2 * m + hf;
                            if (st <= sg) { f32x4 X = (f32x4){0.f, 0.f, 0.f, 0.f};
#pragma unroll
                                for (int kk = 0; kk < 2; ++kk) X = __builtin_amdgcn_mfma_f32_16x16x32_bf16(kf[st][kk], qf[kk], X, 0, 0, 0);
                                if (st == sg) {
#pragma unroll
                                    for (int r = 0; r < 4; ++r) if (4 * q + r > l15) X[r] = 0.f; }
                                pk[2 * hf] = pk2(X[0], X[1]); pk[2 * hf + 1] = pk2(X[2], X[3]); }
                            else { pk[2 * hf] = 0u; pk[2 * hf + 1] = 0u; } }
                        const bf16x8 pa = __builtin_bit_cast(bf16x8, (u32x4){pk[0], pk[1], pk[2], pk[3]});
#pragma unroll
                        for (int et = 0; et < 2; ++et) accO[et] = __builtin_amdgcn_mfma_f32_16x16x32_bf16(vfo[m][et], pa, accO[et], 0, 0, 0);
                    }
                    { char* ob = (char*)O + (size_t)gla_lowrow(b, dir, cidx * 64) * 2048 + (ooff + (unsigned)((dir ? -sg : sg) * 16 * 2048));
#pragma unroll
                        for (int et = 0; et < 2; ++et) { u32x2 w; w.x = pk2(accO[et][0], accO[et][1]); w.y = pk2(accO[et][2], accO[et][3]); *(u32x2*)(ob + 32 * et) = w; } }
                }
            }
            lds_barrier();
            if (cidx >= 0 && cidx < NCH) {
#pragma unroll
                for (int dt = 0; dt < 4; ++dt) { const f32x4 dec = *(const LAS f32x4*)(lds + G_BEND + (16 * dt + 4 * q) * 4); S[dt][0] = S[dt][0] * dec; S[dt][1] = S[dt][1] * dec; }
#pragma unroll
                for (int kk = 0; kk < 2; ++kk) { bf16x8 vs[2];
#pragma unroll
                    for (int et = 0; et < 2; ++et) vs[et] = tr_frag(lds + G_VS + (32 * kk + 8 * q + trq) * G_RSV + (32 * mw + 16 * et + 4 * trp) * 2, 4 * G_RSV);
#pragma unroll
                    for (int dt = 0; dt < 4; ++dt) { const bf16x8 ktf = tr_frag(lds + G_KP + (32 * kk + 8 * q + trq) * G_RS + (16 * dt + 4 * trp) * 2, 4 * G_RS);
                        S[dt][0] = __builtin_amdgcn_mfma_f32_16x16x32_bf16(ktf, vs[0], S[dt][0], 0, 0, 0); S[dt][1] = __builtin_amdgcn_mfma_f32_16x16x32_bf16(ktf, vs[1], S[dt][1], 0, 0, 0); } }
            }
        }
    } else {
        const int pw = wv - 4, ptid = tid - 256;
        bf16x8 wfr[4]; float bu[4];
#pragma unroll
        for (int it = 0; it < 4; ++it) { unsigned w[4] = {0u, 0u, 0u, 0u};
            if (q < 2) {
#pragma unroll
                for (int j = 0; j < 4; ++j) w[j] = pk2(w_up[(size_t)(dir * 16 + 8 * q + 2 * j) * 512 + h * 64 + 16 * it + l15], w_up[(size_t)(dir * 16 + 8 * q + 2 * j + 1) * 512 + h * 64 + 16 * it + l15]); }
            wfr[it] = __builtin_bit_cast(bf16x8, (u32x4){w[0], w[1], w[2], w[3]}); bu[it] = b_up[dir * 512 + h * 64 + 16 * it + l15]; }
        u32x4 graw0; unsigned short qr0[4][4], kr0[4][4]; u32x4 vraw0[4];
        const unsigned goff = (unsigned)((dir ? 63 - (16 * pw + l15) : 16 * pw + l15) * (LDP1 * 2) + (6144 + dir * 16 + 8 * q) * 2);
        unsigned qkoff[4], voff[4];
#pragma unroll
        for (int r = 0; r < 4; ++r) { const int p = 16 * pw + 4 * q + r; qkoff[r] = (unsigned)((dir ? 63 - p : p) * (LDP1 * 2) + (h * 64 + l15) * 2); }
#pragma unroll
        for (int i = 0; i < 4; ++i) { const int piece = ptid + 256 * i, p = piece >> 4, ch = piece & 15; voff[i] = (unsigned)((dir ? 63 - p : p) * (LDP1 * 2) + (5120 + h * 128 + 8 * ch) * 2); }
#define GLA_LOAD(cc, graw, qr, kr, vraw) do { const char* cb = (const char*)P + (size_t)gla_lowrow(b, dir, (cc) * 64) * (LDP1 * 2); \
            graw = (u32x4){0u, 0u, 0u, 0u}; if (q < 2) graw = *(const u32x4*)(cb + goff); \
            _Pragma("unroll") for (int r = 0; r < 4; ++r) { \
                _Pragma("unroll") for (int it = 0; it < 4; ++it) { qr[it][r] = *(const unsigned short*)(cb + (qkoff[r] + (1024 + 16 * it) * 2)); kr[it][r] = *(const unsigned short*)(cb + (qkoff[r] + (4608 + 16 * it) * 2)); } } \
            _Pragma("unroll") for (int i = 0; i < 4; ++i) vraw[i] = *(const u32x4*)(cb + voff[i]); } while (0)
#define GLA_PREP(cidx_, graw, qr, kr, vraw, ngraw, nqr, nkr, nvraw) do { \
            const int cx = (cidx_); LAS unsigned char* ldn = lds0 + ((cx + 1) & 1) * G_END; const bool act = cx + 1 < NCH; \
            lds_barrier();                                                 \
            float la[4][4]; \
            if (act) { const bf16x8 ga = __builtin_bit_cast(bf16x8, graw); \
                _Pragma("unroll") for (int it = 0; it < 4; ++it) { f32x4 z = __builtin_amdgcn_mfma_f32_16x16x32_bf16(ga, wfr[it], (f32x4){bu[it], bu[it], bu[it], bu[it]}, 0, 0, 0); \
                    float c = 0.f; \
                    _Pragma("unroll") for (int r = 0; r < 4; ++r) { const float z2 = z[r] * 1.4426950408889634f; const float ls = (fminf(z2, 0.f) - __builtin_amdgcn_logf(1.f + __builtin_amdgcn_exp2f(-fabsf(z2)))) * 0.0625f; c += ls; la[it][r] = c; }     \
                    float inc = c; { const float t1 = __shfl_up(inc, 16); if (q >= 1) inc += t1; const float t2 = __shfl_up(inc, 32); if (q >= 2) inc += t2; } \
                    const float exq = inc - c; \
                    _Pragma("unroll") for (int r = 0; r < 4; ++r) la[it][r] += exq; \
                    if (q == 3) ((LAS float*)(ldn + G_SEG))[pw * 64 + 16 * it + l15] = inc; } } \
            lds_barrier();                                                 \
            if (act) { \
                _Pragma("unroll") for (int it = 0; it < 4; ++it) { float pre = 0.f, tot = 0.f; \
                    _Pragma("unroll") for (int w = 0; w < 4; ++w) { const float s = ((LAS float*)(ldn + G_SEG))[w * 64 + 16 * it + l15]; tot += s; pre += (w < pw) ? s : 0.f; } \
                    const float etot = __builtin_amdgcn_exp2f(tot); if (pw == 0 && q == 0) ((LAS float*)(ldn + G_BEND))[16 * it + l15] = etot; \
                    _Pragma("unroll") for (int r = 0; r < 4; ++r) { const int p = 16 * pw + 4 * q + r; const float bb = pre + la[it][r]; const float qv = bf2f(qr[it][r]) * 0.125f, kv = bf2f(kr[it][r]); \
                        const int off = p * G_RS + (16 * it + l15) * 2; \
                        const float kt = kv * __builtin_amdgcn_exp2f(-bb); \
                        *(LAS bf16_t*)(ldn + G_QS + off) = (bf16_t)f2bf(qv * __builtin_amdgcn_exp2f(bb)); \
                        *(LAS bf16_t*)(ldn + G_KS + off) = (bf16_t)f2bf(kt); \
                        *(LAS bf16_t*)(ldn + G_KP + off) = (bf16_t)f2bf(kt * etot); } } \
                _Pragma("unroll") for (int i = 0; i < 4; ++i) { const int piece = ptid + 256 * i, p = piece >> 4, ch = piece & 15; *(LAS u32x4*)(ldn + G_VS + p * G_RSV + ch * 16) = vraw[i]; } \
                if (cx + 2 < NCH) GLA_LOAD(cx + 2, ngraw, nqr, nkr, nvraw); } } while (0)
        GLA_LOAD(0, graw0, qr0, kr0, vraw0);
        for (int cidx = -1; cidx < NCH + 1; cidx += 2) {
            GLA_PREP(cidx, graw0, qr0, kr0, vraw0, graw0, qr0, kr0, vraw0);
            GLA_PREP(cidx + 1, graw0, qr0, kr0, vraw0, graw0, qr0, kr0, vraw0);
        }
#undef GLA_PREP
#undef GLA_LOAD
    }
    __syncthreads();
}

constexpr int GM_RS = 288;
constexpr int GM_VT = 0, GM_RSTD = 128 * GM_RS, GM_GN = 40960, GM_BS = 45056;
__device__ __forceinline__ float gelu_fast(float x) { const float y = 1.5957691216057308f * (x + 0.044715f * x * x * x); return x * __builtin_amdgcn_rcpf(1.f + __expf(-y)); }
__device__ __forceinline__ void gmlp_fast_unit(int ci, const bf16_t* P, const float* gnorm, const bf16_t* Wb, const float* bs_, bf16_t* AO, LAS unsigned char* lds) {
    const int tid = threadIdx.x, lane = tid & 63, wv = __builtin_amdgcn_readfirstlane(tid >> 6);
    const int row0 = ci < 128 ? (ci >> 5) * T + (ci & 31) * 128 : M_LAT + ((ci - 128) >> 1) * CL + ((ci - 128) & 1) * 128;
    const int l15 = lane & 15, q = lane >> 4, trq = l15 >> 2, trp = lane & 3;
    LAS float* rs = (LAS float*)(lds + GM_RSTD);
    LAS float* gnl = (LAS float*)(lds + GM_GN); LAS float* bsl = (LAS float*)(lds + GM_BS);
    __syncthreads();
    *(LAS f32x2*)(gnl + 2 * tid) = *(const f32x2*)(gnorm + 2 * tid); *(LAS f32x2*)(bsl + 2 * tid) = *(const f32x2*)(bs_ + 2 * tid);
    { const int row = tid >> 2, qq = tid & 3; const u32x4* vp = (const u32x4*)(P + (size_t)(row0 + row) * LDP0 + 3072 + qq * 256); float ss = 0.f;
#pragma unroll 4
        for (int i = 0; i < 32; ++i) { const u32x4 w = vp[i]; const unsigned ww[4] = {w.x, w.y, w.z, w.w};
#pragma unroll
            for (int c = 0; c < 4; ++c) { const float a0 = gelu_fast(bflo(ww[c])), a1 = gelu_fast(bfhi(ww[c])); ss += a0 * a0 + a1 * a1; } }
        ss += __shfl_xor(ss, 1); ss += __shfl_xor(ss, 2);
        if (qq == 0) rs[row] = rsqrtf(ss * (1.f / 1024.f) + EPS); }
    __syncthreads();
    const int p = 16 * wv + l15;
    for (int g = 0; g < 8; ++g) {
#pragma unroll
        for (int i = 0; i < 4; ++i) { const int id = tid + 512 * i, s = id >> 4, ch = id & 15;
            const u32x4 w = *(const u32x4*)(P + (size_t)(row0 + s) * LDP0 + 3072 + g * 128 + 8 * ch); const unsigned ww[4] = {w.x, w.y, w.z, w.w};
            const float rr = rs[s]; const f32x4 g0 = *(const LAS f32x4*)(gnl + g * 128 + 8 * ch), g1 = *(const LAS f32x4*)(gnl + g * 128 + 8 * ch + 4);
            const float gg[8] = {g0[0], g0[1], g0[2], g0[3], g1[0], g1[1], g1[2], g1[3]};
            unsigned ow[4];
#pragma unroll
            for (int c = 0; c < 4; ++c) ow[c] = pk2(gelu_fast(bflo(ww[c])) * rr * gg[2 * c], gelu_fast(bfhi(ww[c])) * rr * gg[2 * c + 1]);
            *(LAS u32x4*)(lds + GM_VT + s * GM_RS + ch * 16) = (u32x4){ow[0], ow[1], ow[2], ow[3]}; }
        bf16x8 wf[4];
        { const bf16_t* wp = Wb + (size_t)g * 16384 + (size_t)p * 128 + 8 * q;
#pragma unroll
            for (int kk = 0; kk < 4; ++kk) wf[kk] = *(const bf16x8*)(wp + 32 * kk); }
        u32x2 uwv[8];
        { const bf16_t* up_ = P + (size_t)(row0 + p) * LDP0 + 2048 + g * 128 + 4 * q;
#pragma unroll
            for (int ct = 0; ct < 8; ++ct) uwv[ct] = *(const u32x2*)(up_ + 16 * ct); }
        lds_barrier();
        f32x4 acc[8];
#pragma unroll
        for (int ct = 0; ct < 8; ++ct) acc[ct] = (f32x4){0.f, 0.f, 0.f, 0.f};
#pragma unroll
        for (int kk = 0; kk < 4; ++kk)
#pragma unroll
            for (int ct = 0; ct < 8; ++ct) { const bf16x8 vf = tr_frag(lds + GM_VT + (32 * kk + 8 * q + trq) * GM_RS + (16 * ct + 4 * trp) * 2, 4 * GM_RS);
                acc[ct] = __builtin_amdgcn_mfma_f32_16x16x32_bf16(vf, wf[kk], acc[ct], 0, 0, 0); }
        lds_barrier();
        const float bias = bsl[g * 128 + p];
        bf16_t* op = AO + (size_t)(row0 + p) * D + 1024 + g * 128 + 4 * q;
#pragma unroll
        for (int ct = 0; ct < 8; ++ct) { const u32x2 uw = uwv[ct];
            u32x2 o; o.x = pk2(gelu_fast(bflo(uw.x)) * (acc[ct][0] + bias), gelu_fast(bfhi(uw.x)) * (acc[ct][1] + bias));
            o.y = pk2(gelu_fast(bflo(uw.y)) * (acc[ct][2] + bias), gelu_fast(bfhi(uw.y)) * (acc[ct][3] + bias));
            *(u32x2*)(op + 16 * ct) = o; }
    }
}

constexpr int NA_RSK = 272, NA_RSV = 288;
constexpr int NA_KB = 0, NA_VB = 128 * NA_RSK, NA_BUF = 128 * NA_RSK + 128 * NA_RSV;
constexpr int NA_O1 = 0, NA_ML = 4 * 8192;
static_assert(2 * NA_BUF <= LDS_BARW && NA_ML + 1024 <= 2 * NA_BUF, "NA LDS map");
__device__ __forceinline__ void na_fast_unit(int unit, const bf16_t* P, const float* rpb, bf16_t* AO, LAS unsigned char* lds) {
    const int tid = threadIdx.x, lane = tid & 63, wv = __builtin_amdgcn_readfirstlane(tid >> 6);
    const int cq = wv & 3, kh = wv >> 2;
    const int r = unit & 63, h = (unit >> 6) & 7, b = unit >> 9;
    const int l15 = lane & 15, q = lane >> 4, trq = l15 >> 2, trp = lane & 3;
    const int rstart = min(max(r - 4, 0), 56);
    const int col = 16 * cq + l15, cstart = min(max(col - 8, 0), 48);
    const int ct0 = min(max(cq - 1, 0), 1);
    const float scale = 0.08838834764831845f;
    bf16x8 qf[4];
    { const bf16_t* qp = P + (size_t)(b * T + r * 64 + col) * LDP1 + h * 128 + 8 * q;
#pragma unroll
        for (int kk = 0; kk < 4; ++kk) qf[kk] = *(const bf16x8*)(qp + 32 * kk); }
    u32x4 rk[4], rv[4];
#define NA_LOAD(s) do { _Pragma("unroll") for (int i_ = 0; i_ < 4; ++i_) { const int id = tid + 512 * i_, key = id >> 4, ch = id & 15; \
        const int row = (s) < 4 ? b * T + (rstart + 2 * (s) + (key >> 6)) * 64 + (key & 63) : M_LAT + b * CL + 128 * ((s) - 4) + key; \
        const bf16_t* pr = P + (size_t)row * LDP1 + 2560 + h * 128 + 8 * ch; rk[i_] = *(const u32x4*)pr; rv[i_] = *(const u32x4*)(pr + 1024); } } while (0)
#define NA_STORE(bufp) do { _Pragma("unroll") for (int i_ = 0; i_ < 4; ++i_) { const int id = tid + 512 * i_, key = id >> 4, ch = id & 15; \
        *(LAS u32x4*)((bufp) + NA_KB + key * NA_RSK + ch * 16) = rk[i_]; *(LAS u32x4*)((bufp) + NA_VB + key * NA_RSV + ch * 16) = rv[i_]; } } while (0)
    float m = -1.0e30f, l = 0.f;
    f32x4 accO[8];
#pragma unroll
    for (int c = 0; c < 8; ++c) accO[c] = (f32x4){0.f, 0.f, 0.f, 0.f};
    __syncthreads();
    NA_LOAD(0); NA_STORE(lds);
    __syncthreads();
    for (int s = 0; s < 6; ++s) {
        LAS unsigned char* buf = lds + (s & 1) * NA_BUF;
        if (s + 1 < 6) NA_LOAD(s + 1);
        const bool win = s < 4;
        f32x4 sc[4];
        const int kr = rstart + 2 * s + kh;
        const float* bp = rpb + (h * 15 + (win ? kr - r + 7 : 0)) * 31 - col + 15;
#pragma unroll
        for (int j = 0; j < 4; ++j) {
            if (win && j == 3) { sc[j] = (f32x4){-1.0e30f, -1.0e30f, -1.0e30f, -1.0e30f}; }
            else { const int lk = 64 * kh + (win ? 16 * (ct0 + j) : 16 * j) + l15;
                f32x4 X = (f32x4){0.f, 0.f, 0.f, 0.f};
#pragma unroll
                for (int kk = 0; kk < 4; ++kk) { const bf16x8 kf = *(const LAS bf16x8*)(buf + NA_KB + lk * NA_RSK + (32 * kk + 8 * q) * 2); X = __builtin_amdgcn_mfma_f32_16x16x32_bf16(kf, qf[kk], X, 0, 0, 0); }
                if (win) {
#pragma unroll
                    for (int rg = 0; rg < 4; ++rg) { const int kc = 16 * (ct0 + j) + 4 * q + rg; const bool ok = kc >= cstart && kc < cstart + 16;
                        float bias = 0.f; if (ok) bias = bp[kc];
                        sc[j][rg] = ok ? X[rg] * scale + bias : -1.0e30f; }
                } else sc[j] = X * scale; } }
        float ms = fmaxf(fmaxf(fmaxf(sc[0][0], sc[0][1]), fmaxf(sc[0][2], sc[0][3])), fmaxf(fmaxf(sc[1][0], sc[1][1]), fmaxf(sc[1][2], sc[1][3])));
        ms = fmaxf(ms, fmaxf(fmaxf(fmaxf(sc[2][0], sc[2][1]), fmaxf(sc[2][2], sc[2][3])), fmaxf(fmaxf(sc[3][0], sc[3][1]), fmaxf(sc[3][2], sc[3][3]))));
        ms = fmaxf(ms, __shfl_xor(ms, 16)); ms = fmaxf(ms, __shfl_xor(ms, 32));
        const float mn = fmaxf(m, ms), alpha = __expf(m - mn);
        m = mn;
        float ps = 0.f;
#pragma unroll
        for (int j = 0; j < 4; ++j)
#pragma unroll
            for (int rg = 0; rg < 4; ++rg) { const float p = __expf(sc[j][rg] - mn); sc[j][rg] = p; ps += p; }
        l = l * alpha + ps;
        float az[4];
#pragma unroll
        for (int rg = 0; rg < 4; ++rg) az[rg] = __shfl(alpha, 4 * q + rg);
#pragma unroll
        for (int c = 0; c < 8; ++c)
#pragma unroll
            for (int rg = 0; rg < 4; ++rg) accO[c][rg] *= az[rg];
#pragma unroll
        for (int pi = 0; pi < 2; ++pi) {
            const u32x4 pw = (u32x4){pk2(sc[2 * pi][0], sc[2 * pi][1]), pk2(sc[2 * pi][2], sc[2 * pi][3]), pk2(sc[2 * pi + 1][0], sc[2 * pi + 1][1]), pk2(sc[2 * pi + 1][2], sc[2 * pi + 1][3])};
            const bf16x8 pa = __builtin_bit_cast(bf16x8, pw);
            const int lk0 = 64 * kh + (win ? 16 * (ct0 + 2 * pi) : 32 * pi) + 4 * q + trq;
            const int hoff = (win && pi == 1) ? 0 : 16 * NA_RSV;
#pragma unroll
            for (int c = 0; c < 8; ++c) { const bf16x8 vf = tr_frag(buf + NA_VB + lk0 * NA_RSV + (16 * c + 4 * trp) * 2, hoff);
                accO[c] = __builtin_amdgcn_mfma_f32_16x16x32_bf16(pa, vf, accO[c], 0, 0, 0); }
        }
        if (s + 1 < 6) NA_STORE(lds + ((s + 1) & 1) * NA_BUF);
        lds_barrier();
    }
#undef NA_LOAD
#undef NA_STORE
    l += __shfl_xor(l, 16); l += __shfl_xor(l, 32);
    LAS float* ml = (LAS float*)(lds + NA_ML) + (cq * 2 + kh) * 32;
    if (q == 0) { ml[l15] = m; ml[16 + l15] = l; }
    if (kh == 1) { LAS float* o1 = (LAS float*)(lds + NA_O1 + cq * 8192);
#pragma unroll
        for (int c = 0; c < 8; ++c)
#pragma unroll
            for (int rg = 0; rg < 4; ++rg) o1[(4 * q + rg) * 128 + 16 * c + l15] = accO[c][rg]; }
    __syncthreads();
    if (kh == 0) {
        const LAS float* ml0 = (const LAS float*)(lds + NA_ML) + (cq * 2) * 32; const LAS float* ml1 = ml0 + 32;
        const LAS float* o1 = (const LAS float*)(lds + NA_O1 + cq * 8192);
        float f0[4], f1[4];
#pragma unroll
        for (int rg = 0; rg < 4; ++rg) { const int t = 4 * q + rg; const float m0 = ml0[t], m1 = ml1[t], mm = fmaxf(m0, m1);
            const float e0 = __expf(m0 - mm), e1 = __expf(m1 - mm); const float inv = 1.f / (ml0[16 + t] * e0 + ml1[16 + t] * e1);
            f0[rg] = e0 * inv; f1[rg] = e1 * inv; }
#pragma unroll
        for (int rg = 0; rg < 4; ++rg) { bf16_t* op = AO + (size_t)(b * T + r * 64 + 16 * cq + 4 * q + rg) * D + h * 128 + l15;
#pragma unroll
            for (int c = 0; c < 8; ++c) op[16 * c] = (bf16_t)f2bf(accO[c][rg] * f0[rg] + o1[(4 * q + rg) * 128 + 16 * c + l15] * f1[rg]); }
    }
    __syncthreads();
}

__global__ void __launch_bounds__(512, 2) mk_fwd(Args a) {
    extern __shared__ __attribute__((aligned(16))) unsigned char lds_raw[];
    LAS unsigned char* lds = (LAS unsigned char*)lds_raw;
    const int tid = threadIdx.x;
    if (tid < 16) ((LAS unsigned*)(lds + LDS_BARW))[tid] = 0u;
    __syncthreads();
    const int lo = a.lo, hi = a.hi;
    XcdBarrier bar; bar.bar = (unsigned*)(a.ws + WS_CTL) + 4096; bar.x = 0; bar.st = (volatile LAS unsigned*)(lds + LDS_BARW);
    if (hi - lo > 1) bar = xcd_barrier_post((unsigned*)(a.ws + WS_CTL) + 4096, (volatile LAS unsigned*)(lds + LDS_BARW));
#ifdef ONLY_PHASE
#define IN(k) ((k) == ONLY_PHASE && lo <= (k) && (k) < hi)
#else
#define IN(k) (lo <= (k) && (k) < hi)
#endif
#define SEAM(k) do { if (IN(k) && IN((k) + 1)) xcd_barrier(bar); } while (0)
#ifndef DUPMASK
#define DUPMASK 0u
#endif
#define REPS(k) for (int rep = 0; rep < 1 + (int)((DUPMASK >> (k)) & 1u); ++rep)
#define REPBAR() do { if (rep) xcd_barrier(bar); } while (0)
    unsigned char* ws = a.ws;
    float* MOD = (float*)(ws + WS_MOD);
    const float* rotc = (const float*)(ws + WS_ROT); const float* rots = rotc + 2048;
    float* AFF = (float*)(ws + WS_AFF); int* SRC = (int*)(ws + WS_SRC); float* GATE = (float*)(ws + WS_GATE); int* INV = (int*)(ws + WS_INV);
    bf16_t* Win0 = (bf16_t*)(ws + WS_WIN0); bf16_t* Wout0 = (bf16_t*)(ws + WS_WOUT0); bf16_t* Win1 = (bf16_t*)(ws + WS_WIN1); bf16_t* Wout1 = (bf16_t*)(ws + WS_WOUT1);
    bf16_t* Wgu = (bf16_t*)(ws + WS_WGU); bf16_t* Wdn = (bf16_t*)(ws + WS_WDN);
    bf16_t* X1 = (bf16_t*)(ws + WS_X1); bf16_t* Hb = (bf16_t*)(ws + WS_HB); bf16_t* Pb = (bf16_t*)(ws + WS_P); bf16_t* AO = (bf16_t*)(ws + WS_AO);
    float* Of = (float*)(ws + WS_OF); float* Ob = (float*)(ws + WS_OB);
    bf16_t* Xg = (bf16_t*)(ws + WS_XG); bf16_t* Hm = (bf16_t*)(ws + WS_HM); bf16_t* Ye = (bf16_t*)(ws + WS_YE);
    const int G = gridDim.x, bid = blockIdx.x;

    if (IN(0)) REPS(0) { REPBAR(); phase_prologue(a, lds); }
    SEAM(0);
    if (IN(1)) REPS(1) { REPBAR(); phase_modnorm(a.in[I_X], a.in[I_CTX], M_ALL, a.in[I_NMIX], MOD, 0, D, Hb); }
    SEAM(1);
    if (IN(2)) REPS(2) { REPBAR();  pg8::Gemm g{Hb, Win0, D}; pg8::StaticOrder S; S.init(M_ALL, LDP0, G, bid, M_LAT); pg8::EpiStore E{Pb, LDP0}; pg8::gemm_phase(lds, g, S, E); }
    SEAM(2);
    if (IN(3)) {
        for (int i = tid; i < 4096; i += 512) ((LAS float*)(lds + RP_ROT))[i] = rotc[i];
        unsigned* qctr3 = (unsigned*)(ws + WS_CTL) + 8192 + 256;
        for (;;) {
            __syncthreads();
            if (tid == 0) *(volatile LAS unsigned*)(lds + LDS_BARW + 32) = atomicAdd(qctr3, 1u);
            __syncthreads();
            const unsigned u = *(volatile LAS unsigned*)(lds + LDS_BARW + 32);
            if (u >= 136u + (unsigned)(NB * 8 * NRC)) break;
            if (u < 136u) gmlp_fast_unit((int)u, Pb, a.in[I_GMLPN], (const bf16_t*)(ws + WS_GMW), a.in[I_GMLPB], AO, lds);
            else retp_kv_unit((int)u - 136, Pb, rotc, a.in[I_GAMMA], (bf16_t*)(ws + WS_OF), lds);
        }
    }
    if (IN(3) && IN(4)) xcd_barrier(bar);
    if (IN(4)) { for (int u = bid; u < NB * 8 * 2 * 4; u += G) retp_scan_unit(u, a.in[I_GAMMA], (const bf16_t*)(ws + WS_OF), (bf16_t*)(ws + WS_OB)); }
    if (IN(4) && IN(8)) xcd_barrier(bar);
    if (IN(8)) {
        for (int i = tid; i < 4096; i += 512) ((LAS float*)(lds + RP_ROT))[i] = rotc[i];
        for (int u = bid; u < NB * 8 * NRC; u += G) retp_out_unit(u, Pb, rotc, a.in[I_GAMMA], (const bf16_t*)(ws + WS_OB), a.in[I_RETN], AO, lds);
    }
    if (IN(8) && IN(5)) xcd_barrier(bar);
    if (IN(5)) REPS(5) { REPBAR();  pg8::Gemm g{AO, Wout0, D}; pg8::StaticOrder S; S.init(M_ALL, D, G, bid, M_LAT); pg8::EpiResid<false> E{a.in[I_X], a.in[I_CTX], X1, MOD + 2 * D}; pg8::gemm_phase(lds, g, S, E); }
    SEAM(5);
    if (IN(6)) REPS(6) { REPBAR(); phase_modnorm_router(X1, M_ALL, a.in[I_NFFN], MOD, 3 * D, 4 * D, Hb, a.in[I_ROUTER], AFF, lds); }
    SEAM(6);
    if (IN(7)) REPS(7) { REPBAR(); phase_topk(AFF, SRC, GATE, INV, RPE0, true, lds); }
    if (IN(7) && IN(9)) xcd_barrier(bar);
    if (IN(9)) REPS(9) { REPBAR();  pg8::Gemm g{Hb, Wgu, D}; pg8::MoeOrder S; S.init(RPE0 / 256, 16, G, bid, 8); pg8::EpiSiluMul E{Hm}; pg8::gemm_phase<pg8::EpiSiluMul, pg8::MoeOrder, true>(lds, g, S, E, SRC); }
    SEAM(9);
    if (IN(10)) REPS(10) { REPBAR();  pg8::Gemm g{Hm, nullptr, D}; pg8::BSrcF32 bs{a.in[I_WDOWN], a.in[I_WDOWN], 8, 256, 128}; pg8::MoeOrder S; S.init(RPE0 / 256, 8, G, bid, 8); pg8::EpiStore E{Ye, D}; pg8::gemm_phase_fb<pg8::EpiStore, pg8::MoeOrder, false, true>(lds, g, bs, S, E); }
    SEAM(10);
    if (IN(11)) REPS(11) { REPBAR(); phase_moe_combine<false>(X1, Ye, INV, GATE, MOD + 5 * D, M_ALL, a.in[I_NMIX] + D, MOD + 5 * 12288, Hb, nullptr); }
    SEAM(11);
    if (IN(12)) REPS(12) { REPBAR();  pg8::Gemm g{Hb, Win1, D}; pg8::StaticOrderTailCols<10> S; S.init(M_ALL, LDP1, G, bid, M_LAT); pg8::EpiStore E{Pb, LDP1}; pg8::gemm_phase(lds, g, S, E); }
    SEAM(12);
    if (IN(13)) REPS(13) {
        REPBAR();
        if (bid < 64) { gla_fast_unit(bid, Pb, a.in[I_GLAWUP], a.in[I_GLABUP], Of, Ob, lds); }
        unsigned* qctr = (unsigned*)(ws + WS_CTL) + 8192 + 64 * rep;
        for (;;) {
            __syncthreads();
            if (tid == 0) *(volatile LAS unsigned*)(lds + LDS_BARW + 32) = atomicAdd(qctr, 1u);
            __syncthreads();
            const unsigned u = *(volatile LAS unsigned*)(lds + LDS_BARW + 32);
            if (u >= (unsigned)(NB * 8 * 64)) break;
            na_fast_unit((int)u, Pb, a.in[I_RPB], AO, lds);
        }
    }
    SEAM(13);
    if (IN(14)) REPS(14) { REPBAR(); phase_head_combine_bf16((const bf16_t*)Of, (const bf16_t*)Ob, Pb, LDP1, 1536, a.in[I_GLAN], AO, 1024, M_LAT); }
    SEAM(14);
    if (IN(15)) REPS(15) { REPBAR();  pg8::Gemm g{AO, Wout1, D}; pg8::StaticOrder S; S.init(M_LAT, D, G, bid); pg8::EpiResid<true> E{nullptr, nullptr, X1, MOD + 5 * 12288 + 2 * D}; pg8::gemm_phase(lds, g, S, E); }
    SEAM(15);
    if (IN(16)) REPS(16) { REPBAR(); phase_modnorm_router(X1, M_LAT, a.in[I_NFFN] + D, MOD + 5 * 12288, 3 * D, 4 * D, Hb, a.in[I_ROUTER] + (size_t)D * NE, AFF, lds); }
    SEAM(16);
    if (IN(17)) REPS(17) { REPBAR(); phase_topk(AFF, SRC, GATE, INV, RPE1, false, lds); }
    if (IN(17) && IN(19)) xcd_barrier(bar);
    if (IN(19)) REPS(19) { REPBAR();  pg8::Gemm g{Hb, Wgu + (size_t)NE * 4096 * 2048, D}; pg8::MoeOrder S; S.init(RPE1 / 256, 16, G, bid); pg8::EpiSiluMul E{Hm}; pg8::gemm_phase<pg8::EpiSiluMul, pg8::MoeOrder, true>(lds, g, S, E, SRC); }
    SEAM(19);
    if (IN(20)) REPS(20) { REPBAR();  pg8::Gemm g{Hm, nullptr, D}; pg8::BSrcF32 bs{a.in[I_WDOWN] + (size_t)NE * 2048 * 2048, a.in[I_WDOWN] + (size_t)NE * 2048 * 2048, 8, 256, 128}; pg8::MoeOrder S; S.init(RPE1 / 256, 8, G, bid); pg8::EpiStore E{Ye, D}; pg8::gemm_phase_fb<pg8::EpiStore, pg8::MoeOrder, false>(lds, g, bs, S, E); }
    SEAM(20);
    if (IN(21)) REPS(21) { REPBAR(); phase_moe_combine<true>(X1, Ye, INV, GATE, MOD + 5 * 12288 + 5 * D, M_LAT, a.in[I_NFIN], nullptr, nullptr, a.out); }
#undef IN
#undef SEAM
}

extern "C" void kernel_launch(void* const* d_in, const int* in_sizes, int n_in, void* d_out, int out_size, void* d_ws, size_t ws_size, hipStream_t stream) {
    static int grid = 0;
    if (grid == 0) {
        if (n_in != 26 || out_size != M_LAT * D || ws_size < WS_END) { fprintf(stderr, "kernel_launch: unexpected problem (n_in %d, out %d, ws %zu < %zu)\n", n_in, out_size, ws_size, (size_t)WS_END); grid = -1; return; }
        int dev = 0, cus = 0, per_cu = 0;
        if (hipGetDevice(&dev) != hipSuccess || hipDeviceGetAttribute(&cus, hipDeviceAttributeMultiprocessorCount, dev) != hipSuccess) { grid = -1; return; }
        if (hipFuncSetAttribute((const void*)mk_fwd, hipFuncAttributeMaxDynamicSharedMemorySize, LDS_BYTES) != hipSuccess) { fprintf(stderr, "kernel_launch: hipFuncSetAttribute failed\n"); grid = -1; return; }
        if (hipOccupancyMaxActiveBlocksPerMultiprocessor(&per_cu, (const void*)mk_fwd, 512, LDS_BYTES) != hipSuccess || per_cu < 1) fprintf(stderr, "kernel_launch: occupancy query says %d\n", per_cu);
        (void)hipGetLastError();
        grid = cus;
    }
    if (grid < 0) return;
    (void)hipMemsetAsync((char*)d_ws + WS_CTL, 0, CTL_BYTES, stream);
    Args a{};
    for (int i = 0; i < 26; ++i) a.in[i] = (const float*)d_in[i];
    a.out = (float*)d_out; a.ws = (unsigned char*)d_ws;
#if MK_SPLIT
    { const int order[20] = {0, 1, 2, 3, 4, 8, 5, 6, 7, 9, 10, 11, 12, 13, 14, 15, 16, 17, 19, 20};
        for (int i = 0; i < 20; ++i) { a.lo = order[i]; a.hi = order[i] + 1; hipLaunchKernelGGL(mk_fwd, dim3(grid), dim3(512), LDS_BYTES, stream, a); }
        a.lo = 21; a.hi = 22; hipLaunchKernelGGL(mk_fwd, dim3(grid), dim3(512), LDS_BYTES, stream, a); }
#else
    a.lo = 0; a.hi = NPH; hipLaunchKernelGGL(mk_fwd, dim3(grid), dim3(512), LDS_BYTES, stream, a);
#endif
}
```

```cpp
#include <hip/hip_runtime.h>
#include <cstdio>
#include <cstdint>

#ifndef MK_SPLIT
#define MK_SPLIT 0
#endif

#define LAS __attribute__((address_space(3)))
typedef unsigned short bf16_t;
typedef short bf16x8 __attribute__((ext_vector_type(8)));
typedef float f32x4 __attribute__((ext_vector_type(4)));
typedef float f32x2 __attribute__((ext_vector_type(2)));
typedef unsigned u32x4 __attribute__((ext_vector_type(4)));
typedef unsigned u32x2 __attribute__((ext_vector_type(2)));
typedef short s16x4 __attribute__((ext_vector_type(4)));

constexpr int D = 2048, NB = 4, T = 4096, CL = 256, NE = 16;
constexpr int M_LAT = NB * T, M_CTX = NB * CL, M_ALL = M_LAT + M_CTX;
constexpr float EPS = 1e-6f;
constexpr int LDP0 = 6144, LDP1 = 6400;
constexpr int RPE0 = 2304, RPE1 = 2048;
constexpr int NPH = 22;

constexpr size_t MiB = 1u << 20;
constexpr size_t WS_CTL = 0, CTL_BYTES = 1 * MiB;
constexpr size_t WS_MOD = 1 * MiB;
constexpr size_t WS_ROT = 2 * MiB;
constexpr size_t WS_GMW = 2 * MiB + 512 * 1024;
constexpr size_t WS_AFF = 3 * MiB;
constexpr size_t WS_SRC = 5 * MiB;
constexpr size_t WS_GATE = 6 * MiB;
constexpr size_t WS_INV = 7 * MiB;
constexpr size_t WS_WIN0 = 16 * MiB, WS_WOUT0 = 40 * MiB, WS_WIN1 = 48 * MiB, WS_WOUT1 = 74 * MiB;
constexpr size_t WS_WGU = 82 * MiB;
constexpr size_t WS_WDN = 594 * MiB;
constexpr size_t WS_X1 = 850 * MiB;
constexpr size_t WS_HB = 986 * MiB;
constexpr size_t WS_P = 1054 * MiB;
constexpr size_t WS_AO = 1267 * MiB;
constexpr size_t WS_OF = 1335 * MiB, WS_OB = 1403 * MiB;
constexpr size_t WS_XG = 1471 * MiB, WS_HM = 1615 * MiB, WS_YE = 1759 * MiB;
constexpr size_t WS_END = 1903 * MiB;

constexpr int LDS_BYTES = 147456;
constexpr int LDS_BARW = LDS_BYTES - 64;

__device__ __forceinline__ float bf2f(unsigned v) { return __uint_as_float(v << 16); }
__device__ __forceinline__ float bflo(unsigned w) { return __uint_as_float(w << 16); }
__device__ __forceinline__ float bfhi(unsigned w) { return __uint_as_float(w & 0xffff0000u); }
typedef __bf16 bf2_t __attribute__((ext_vector_type(2)));
__device__ __forceinline__ unsigned f2bf(float f) { return (unsigned)__builtin_bit_cast(unsigned short, (__bf16)f); }
__device__ __forceinline__ unsigned pk2(float lo, float hi) { bf2_t v; v[0] = (__bf16)lo; v[1] = (__bf16)hi; return __builtin_bit_cast(unsigned, v); }
__device__ __forceinline__ float silu_f(float x) { return x / (1.f + __expf(-x)); }
__device__ __forceinline__ float gelu_tanh_f(float x) { const float y = 0.7978845608028654f * (x + 0.044715f * x * x * x); return x / (1.f + __expf(-2.f * y)); }
__device__ __forceinline__ float wave_sum(float v) {
#pragma unroll
    for (int o = 1; o < 64; o <<= 1) v += __shfl_xor(v, o);
    return v;
}
__device__ __forceinline__ float wave_max(float v) {
#pragma unroll
    for (int o = 1; o < 64; o <<= 1) v = fmaxf(v, __shfl_xor(v, o));
    return v;
}

__device__ __forceinline__ void lds_barrier() { asm volatile("s_waitcnt lgkmcnt(0)" ::: "memory"); __builtin_amdgcn_s_barrier(); asm volatile("" ::: "memory"); }
#define XB_TMO      128
#define XB_XCNT(j)  (256  + 64 * (j))
#define XB_XSUB(j)  (1280 + 64 * (j))
#define XB_XGEN(j)  (2304 + 64 * (j))
#define XB_TOP      3328
#define XB_TOPGEN   3392
#define XCD_BAR_WORDS 3456
#define XB_SPIN_CAP (1u << 18)
__device__ __forceinline__ unsigned xb_ld(unsigned* p)              { return __hip_atomic_load(p, __ATOMIC_RELAXED, __HIP_MEMORY_SCOPE_AGENT); }
__device__ __forceinline__ unsigned xb_add(unsigned* p, unsigned v) { return __hip_atomic_fetch_add(p, v, __ATOMIC_RELAXED, __HIP_MEMORY_SCOPE_AGENT); }
__device__ __forceinline__ unsigned xb_xcc_id() { return (unsigned)__builtin_amdgcn_s_getreg((3 << 11) | 20) & 0xFu; }
#define XB_SPIN(cond, bar) do { unsigned _sp = 0; while (cond) { __builtin_amdgcn_s_sleep(1); \
    if ((++_sp & 255u) == 0u) { if (xb_ld(&(bar)[XB_TMO])) break; if (_sp > XB_SPIN_CAP) { atomicAdd(&(bar)[XB_TMO], 1u); break; } } } } while (0)
struct XcdBarrier { unsigned* bar; unsigned x; volatile LAS unsigned* st; };
__device__ __forceinline__ XcdBarrier xcd_barrier_post(unsigned* bar, volatile LAS unsigned* st) {
    XcdBarrier b; b.bar = bar; b.x = xb_xcc_id(); b.st = st;
    if (threadIdx.x == 0) (void)xb_add(&bar[XB_XCNT(b.x)], 1u);
    return b;
}
__device__ __forceinline__ void xcd_barrier_complete(unsigned* bar, unsigned x, unsigned& nloc, unsigned& nx) {
    const unsigned G = gridDim.x * gridDim.y * gridDim.z;
    unsigned sum, cnt, mine, sp = 0u;
    for (;;) {
        sum = 0u; cnt = 0u; mine = 0u;
#pragma unroll
        for (unsigned j = 0; j < 16; ++j) { const unsigned c = xb_ld(&bar[XB_XCNT(j)]); sum += c; cnt += (c > 0u) ? 1u : 0u; mine = (j == x) ? c : mine; }
        if (sum == G) break;
        __builtin_amdgcn_s_sleep(1);
        if ((++sp & 255u) == 0u) { if (xb_ld(&bar[XB_TMO])) break; if (sp > XB_SPIN_CAP) { atomicAdd(&bar[XB_TMO], 1u); break; } }
    }
    nloc = mine > 0u ? mine : 1u; nx = cnt > 0u ? cnt : 1u;
}
__device__ __forceinline__ void xcd_barrier(const XcdBarrier& b) {
    asm volatile("s_waitcnt vmcnt(0)" ::: "memory");
    __syncthreads();
    if (threadIdx.x == 0) {
        unsigned* bar = b.bar;
        __builtin_amdgcn_s_waitcnt(0);
        unsigned nloc = b.st[0], nx = b.st[1];
        if (nloc == 0u) { xcd_barrier_complete(bar, b.x, nloc, nx); b.st[0] = nloc; b.st[1] = nx; }
        const unsigned old = xb_add(&bar[XB_XSUB(b.x)], 1u);
        const unsigned gen = old / nloc;
        if (old + 1u == (gen + 1u) * nloc) {
            __builtin_amdgcn_fence(__ATOMIC_RELEASE, "agent");
            asm volatile("s_waitcnt vmcnt(0)" ::: "memory");
            const unsigned og = xb_add(&bar[XB_TOP], 1u);
            const unsigned tg = og / nx;
            if (og + 1u == (tg + 1u) * nx) xb_add(&bar[XB_TOPGEN], 1u);
            else XB_SPIN(xb_ld(&bar[XB_TOPGEN]) == tg, bar);
            __builtin_amdgcn_fence(__ATOMIC_ACQUIRE, "agent");
            xb_add(&bar[XB_XGEN(b.x)], 1u);
            asm volatile("s_waitcnt vmcnt(0)" ::: "memory");
        } else {
            XB_SPIN(xb_ld(&bar[XB_XGEN(b.x)]) == gen, bar);
            __builtin_amdgcn_fence(__ATOMIC_ACQUIRE, "agent");
            asm volatile("s_waitcnt vmcnt(0)" ::: "memory");
        }
    }
    __syncthreads();
}

namespace pg8 {
constexpr int BM = 256, BK = 64, HALF = 128, HTB = HALF * BK * 2, STAGE_BYTES = 8 * HTB, NXCD = 8, WGM = 8;
__host__ __device__ __forceinline__ int lds_byte(int r, int c) { const int st = (r >> 4) * 2 + (c >> 5), rr = r & 15, cc = c & 31, ob = rr * 64 + cc * 2; return st * 1024 + (ob ^ (((ob >> 9) & 1) << 5)); }
__host__ __device__ __forceinline__ void stage_rc(int b, int& R, int& C) { const int st = b / 1024, sb = b % 1024, swz = sb ^ (((sb >> 9) & 1) << 5); R = (st >> 1) * 16 + swz / 64; C = (st & 1) * 32 + (swz % 64) / 2; }
__host__ __device__ __forceinline__ int perm32(int rho) { const int n = rho >> 4, i = rho & 15; return 8 * (i >> 2) + 4 * n + (i & 3); }
struct Unit { int pm, pn, pc, hf; };
struct Gemm { const bf16_t* A; const bf16_t* Bt; int K; };
struct StaticOrder {
    int nM, nMf, nN, nwgF, nwg, G, c;
    __device__ void init(int M, int N, int G_, int c_, int Mfull = -1) { nM = M / BM; nMf = (Mfull < 0 ? M : Mfull) / BM; nN = N / BM; nwgF = nMf * nN; nwg = nwgF + 2 * (nM - nMf) * nN; G = G_; c = c_; }
    __device__ bool next(int i, Unit& u) const {
        const long L = (long)i * G + c; if (L >= nwg) return false;
        if (L < nwgF) {
            int wgid = (int)L; { const int q = nwgF / NXCD, r = nwgF % NXCD, xcd = wgid % NXCD, off = wgid / NXCD; wgid = (xcd < r ? xcd * (q + 1) : r * (q + 1) + (xcd - r) * q) + off; }
            const int nig = WGM * nN, gid = wgid / nig, fm = gid * WGM, gsz = (nMf - fm) < WGM ? (nMf - fm) : WGM;
            u.pm = fm + ((wgid % nig) % gsz); u.pn = (wgid % nig) / gsz; u.hf = 0;
        } else { const int r = (int)L - nwgF, xcd = r % NXCD, j = r / NXCD, nT2 = 2 * (nM - nMf), perX = (nwg - nwgF) / NXCD, idx = xcd * perX + j;
            u.pn = idx / nT2; u.pm = nMf + ((idx % nT2) >> 1); u.hf = 1 + (idx & 1); }
        u.pc = u.pn; return true;
    }
    __device__ __forceinline__ void a_ready(const Unit&) const {}
    __device__ __forceinline__ void done(const Unit&) const {}
};
template <int CN0>
struct StaticOrderTailCols {
    int nM, nMf, nN, nwgF, nFull, perXF, perXL, nCtxU, nwg, G, c;
    __device__ void init(int M, int N, int G_, int c_, int Mfull) { nM = M / BM; nMf = Mfull / BM; nN = N / BM; nwgF = nMf * nN; G = G_; c = c_;
        nFull = (nwgF / G) * G; perXF = nFull / NXCD; perXL = (nwgF - nFull) / NXCD;
        nCtxU = (nM - nMf) * (nN - CN0); nwg = nFull + 2 * (nwgF - nFull) + 2 * nCtxU; }
    __device__ __forceinline__ void unit_of(int wgid, Unit& u) const { const int nig = WGM * nN, gid = wgid / nig, fm = gid * WGM, gsz = (nMf - fm) < WGM ? (nMf - fm) : WGM;
        u.pm = fm + ((wgid % nig) % gsz); u.pn = (wgid % nig) / gsz; }
    __device__ bool next(int i, Unit& u) const {
        const long L = (long)i * G + c; if (L >= nwg) return false;
        const int q = nwgF / NXCD;
        if (L < nFull) { const int xcd = (int)L % NXCD, off = (int)L / NXCD; unit_of(xcd * q + off, u); u.hf = 0; }
        else { const int r = (int)L - nFull, nL2 = 2 * (nwgF - nFull);
            if (r < nL2) { const int xcd = r % NXCD, j = r / NXCD; unit_of(xcd * q + perXF + (j >> 1), u); u.hf = 1 + (j & 1); }
            else { const int cidx = r - nL2, t = cidx >> 1, nT = nM - nMf; u.pm = nMf + t % nT; u.pn = CN0 + t / nT; u.hf = 1 + (cidx & 1); } }
        u.pc = u.pn; return true;
    }
    __device__ __forceinline__ void a_ready(const Unit&) const {}
    __device__ __forceinline__ void done(const Unit&) const {}
};
struct MoeOrder {
    int RT, RTf, CT, nwg, G, c;
    __device__ void init(int RT_, int CT_, int G_, int c_, int RTf_ = -1) { RT = RT_; RTf = RTf_ < 0 ? RT_ : RTf_; CT = CT_; nwg = NE * RT * CT; G = G_; c = c_; }
    __device__ bool next(int i, Unit& u) const {
        const long L0 = (long)i * G + c; if (L0 >= nwg) return false;
        int L = (int)L0; { const int q = nwg / NXCD, r = nwg % NXCD, xcd = L % NXCD, off = L / NXCD; L = (xcd < r ? xcd * (q + 1) : r * (q + 1) + (xcd - r) * q) + off; }
        const int per = RT * CT, e = L / per, rem = L % per, pnl = rem / RT, pml = rem % RT;
        u.pm = e * RT + pml; u.pn = e * CT + pnl; u.pc = pnl; u.hf = pml >= RTf ? 1 : 0; return true;
    }
    __device__ __forceinline__ void a_ready(const Unit&) const {}
    __device__ __forceinline__ void done(const Unit&) const {}
};

template <class Epi, class Sched, bool GATHER = false>
__device__ __forceinline__ void gemm_phase(LAS unsigned char* lds, const Gemm g, const Sched& S, const Epi& E, const int* src = nullptr) {
    const int tid = threadIdx.x, wid = __builtin_amdgcn_readfirstlane(tid >> 6), lane = tid & 63, wr = wid >> 2, wc = wid & 3, fr = lane & 15, fq = lane >> 4;
    const int K = g.K, nt = K / BK;
    unsigned voffA[2][2], voffN[2][2], voffB[2];
    int stR[2], stC[2];
#pragma unroll
    for (int i = 0; i < 2; ++i) { int R, C; stage_rc(tid * 16 + i * 8192, R, C); stR[i] = R; stC[i] = C; const int Rb = Epi::PERM ? ((R & ~31) + perm32(R & 31)) : R;
        voffA[0][i] = (unsigned)(R * K + C) * 2u; voffA[1][i] = voffA[0][i]; voffN[0][i] = voffA[0][i]; voffN[1][i] = voffA[0][i]; voffB[i] = (unsigned)(Rb * K + C) * 2u; }
    const size_t kstep = (size_t)(BK * 2);
    const size_t hstep = (size_t)HALF * K * 2;
    const size_t tstep = 2 * hstep;
    const size_t hstepA = GATHER ? 0 : hstep;
    const unsigned ldsw = (unsigned)wid * 1024u;
    const int aoff = lds_byte(wr * 64 + fr, fq * 8), boff = lds_byte(wc * 32 + fr, fq * 8);
#define PG8_SA(b, h) (((b) * 2 + (h)) * HTB)
#define PG8_SB(b, h) ((4 + (b) * 2 + (h)) * HTB)
#define PG8_STAGE(bufoff, gbase, voff) do { _Pragma("unroll") for (int _i = 0; _i < 2; ++_i) \
        __builtin_amdgcn_global_load_lds((const unsigned*)((const char*)(gbase) + (voff)[_i]), (LAS unsigned*)(lds + (bufoff) + ldsw + _i * 8192), 16, 0, 0); } while (0)
#define PG8_GOFF(dst, pmv) do { if (GATHER) { _Pragma("unroll") for (int _h = 0; _h < 2; ++_h) _Pragma("unroll") for (int _i = 0; _i < 2; ++_i) \
        dst[_h][_i] = ((unsigned)src[(pmv) * BM + _h * HALF + stR[_i]] * (unsigned)K + (unsigned)stC[_i]) * 2u; } } while (0)
#define PG8_LDA(dst, b, h) do { _Pragma("unroll") for (int m = 0; m < 4; ++m) _Pragma("unroll") for (int k = 0; k < 2; ++k) dst[m][k] = *(const LAS bf16x8*)(lds + PG8_SA(b, h) + aoff + m * 2048 + k * 1024); } while (0)
#define PG8_LDB(dst, b, h) do { _Pragma("unroll") for (int n = 0; n < 2; ++n) _Pragma("unroll") for (int k = 0; k < 2; ++k) dst[n][k] = *(const LAS bf16x8*)(lds + PG8_SB(b, h) + boff + n * 2048 + k * 1024); } while (0)
#define PG8_MMA(ai, bj, At, Bt) do { __builtin_amdgcn_s_setprio(1); _Pragma("unroll") for (int m = 0; m < 4; ++m) _Pragma("unroll") for (int n = 0; n < 2; ++n) _Pragma("unroll") for (int k = 0; k < 2; ++k) \
        acc[ai][bj][m][n] = __builtin_amdgcn_mfma_f32_16x16x32_bf16(Bt[n][k], At[m][k], acc[ai][bj][m][n], 0, 0, 0); __builtin_amdgcn_s_setprio(0); } while (0)
#define PG8_WAIT_V(n) asm volatile("s_waitcnt vmcnt(" #n ")" ::: "memory")
#define PG8_WAIT_L(n) asm volatile("s_waitcnt lgkmcnt(" #n ")" ::: "memory")
#define PG8_BAR __builtin_amdgcn_s_barrier()
#define PG8_SCHED __builtin_amdgcn_sched_barrier(0)
    Unit cur, nxt; int ui = 0;
    if (!S.next(0, cur)) return;
    f32x4 acc[2][2][4][2];
#pragma unroll
    for (int a = 0; a < 2; ++a)
#pragma unroll
        for (int b = 0; b < 2; ++b)
#pragma unroll
            for (int m = 0; m < 4; ++m)
#pragma unroll
                for (int n = 0; n < 2; ++n) acc[a][b][m][n] = (f32x4){0.f, 0.f, 0.f, 0.f};
    bf16x8 At[4][2], B0[2][2], B1[2][2];
#define PG8_ABASE(u) ((const char*)g.A + (GATHER ? (size_t)0 : (size_t)(u).pm * tstep + ((u).hf == 2 ? hstep : (size_t)0)))
    const char* cA = PG8_ABASE(cur); const char* cB = (const char*)g.Bt + (size_t)cur.pn * tstep;
    size_t cHA = cur.hf ? (size_t)0 : hstepA; bool full = cur.hf == 0;
    PG8_GOFF(voffA, cur.pm);
    S.a_ready(cur);
    PG8_STAGE(PG8_SB(0, 0), cB, voffB); PG8_STAGE(PG8_SA(0, 0), cA, voffA[0]); PG8_STAGE(PG8_SB(0, 1), cB + hstep, voffB); PG8_STAGE(PG8_SA(0, 1), cA + cHA, voffA[1]);
    if (wr == 1) PG8_BAR;
    PG8_WAIT_V(4); PG8_BAR;
    PG8_STAGE(PG8_SB(1, 0), cB + kstep, voffB); PG8_STAGE(PG8_SA(1, 0), cA + kstep, voffA[0]); PG8_STAGE(PG8_SB(1, 1), cB + hstep + kstep, voffB);
    PG8_WAIT_V(6); PG8_BAR;
    for (;;) {
        const bool has_next = S.next(ui + 1, nxt);
        const size_t nHA = has_next ? (nxt.hf ? (size_t)0 : hstepA) : cHA;
        const char* nA = (has_next && !GATHER) ? PG8_ABASE(nxt) : cA; const char* nB = has_next ? (const char*)g.Bt + (size_t)nxt.pn * tstep : cB;
        if (GATHER) { if (has_next) PG8_GOFF(voffN, nxt.pm); else {
#pragma unroll
            for (int _h = 0; _h < 2; ++_h)
#pragma unroll
                for (int _i = 0; _i < 2; ++_i) voffN[_h][_i] = voffA[_h][_i]; } }
        for (int t = 0; t < nt; t += 2) {
            const bool last = (t == nt - 2);
            const char* a1 = cA + (size_t)(t + 1) * kstep;
            const char* a2 = last ? nA : cA + (size_t)(t + 2) * kstep; const char* b2 = last ? nB : cB + (size_t)(t + 2) * kstep;
            const char* a3 = a2 + kstep; const char* b3 = b2 + kstep;
            unsigned va2[2][2];
#pragma unroll
            for (int _h = 0; _h < 2; ++_h)
#pragma unroll
                for (int _i = 0; _i < 2; ++_i) va2[_h][_i] = (GATHER && last) ? voffN[_h][_i] : voffA[_h][_i];
            if (last && has_next) S.a_ready(nxt);
            PG8_LDB(B0, 0, 0); PG8_SCHED; PG8_LDA(At, 0, 0); PG8_STAGE(PG8_SA(1, 1), a1 + cHA, voffA[1]);
            PG8_WAIT_L(8); PG8_BAR; PG8_WAIT_L(0); PG8_MMA(0, 0, At, B0); PG8_BAR; PG8_SCHED;
            PG8_LDB(B1, 0, 1); PG8_STAGE(PG8_SB(0, 0), b2, voffB);
            PG8_BAR; PG8_WAIT_L(0); PG8_MMA(0, 1, At, B1); PG8_BAR;
            if (full) PG8_LDA(At, 0, 1); PG8_STAGE(PG8_SA(0, 0), a2, va2[0]);
            PG8_BAR; PG8_WAIT_L(0); if (full) PG8_MMA(1, 0, At, B0); PG8_BAR; PG8_SCHED;
            PG8_STAGE(PG8_SB(0, 1), b2 + hstep, voffB);
            PG8_WAIT_V(6); PG8_BAR; if (full) PG8_MMA(1, 1, At, B1); PG8_BAR;
            PG8_LDB(B0, 1, 0); PG8_SCHED; PG8_LDA(At, 1, 0); PG8_STAGE(PG8_SA(0, 1), a2 + (last ? nHA : cHA), va2[1]);
            PG8_WAIT_L(8); PG8_BAR; PG8_WAIT_L(0); PG8_MMA(0, 0, At, B0); PG8_BAR; PG8_SCHED;
            PG8_LDB(B1, 1, 1); PG8_STAGE(PG8_SB(1, 0), b3, voffB);
            PG8_BAR; PG8_WAIT_L(0); PG8_MMA(0, 1, At, B1); PG8_BAR;
            if (full) PG8_LDA(At, 1, 1); PG8_STAGE(PG8_SA(1, 0), a3, va2[0]);
            PG8_BAR; PG8_WAIT_L(0); if (full) PG8_MMA(1, 0, At, B0); PG8_BAR; PG8_SCHED;
            PG8_STAGE(PG8_SB(1, 1), b3 + hstep, voffB);
            PG8_WAIT_V(6); PG8_BAR; if (full) PG8_MMA(1, 1, At, B1); PG8_BAR;
        }
        E(acc, cur, wr, wc, fr, fq); S.done(cur);
        if (!has_next) break;
#pragma unroll
        for (int a = 0; a < 2; ++a)
#pragma unroll
            for (int b = 0; b < 2; ++b)
#pragma unroll
                for (int m = 0; m < 4; ++m)
#pragma unroll
                    for (int n = 0; n < 2; ++n) acc[a][b][m][n] = (f32x4){0.f, 0.f, 0.f, 0.f};
        cur = nxt; cA = nA; cB = nB; cHA = nHA; full = cur.hf == 0; ++ui;
        if (GATHER) {
#pragma unroll
            for (int _h = 0; _h < 2; ++_h)
#pragma unroll
                for (int _i = 0; _i < 2; ++_i) voffA[_h][_i] = voffN[_h][_i]; }
    }
    PG8_WAIT_V(0);
    if (wr == 0) PG8_BAR;
    PG8_BAR;
#undef PG8_SA
#undef PG8_SB
#undef PG8_STAGE
#undef PG8_GOFF
#undef PG8_ABASE
#undef PG8_LDA
#undef PG8_LDB
#undef PG8_MMA
#undef PG8_WAIT_V
#undef PG8_WAIT_L
#undef PG8_BAR
#undef PG8_SCHED
}

struct BSrcF32 { const float* b0; const float* b1; int CT, cstep, hoff; };
template <class Epi, class Sched, bool GATHER, bool HALFU = false>
__device__ __forceinline__ void gemm_phase_fb(LAS unsigned char* lds, const Gemm g, const BSrcF32 bs, const Sched& S, const Epi& E, const int* src = nullptr) {
    static_assert(Epi::PERM, "gemm_phase_fb: permuted weight columns only");
    const int tid = threadIdx.x, wid = __builtin_amdgcn_readfirstlane(tid >> 6), lane = tid & 63, wr = wid >> 2, wc = wid & 3, fr = lane & 15, fq = lane >> 4;
    const int K = g.K, nt = K / BK;
    unsigned voffA[2][2], voffN[2][2];
#pragma unroll
    for (int i = 0; i < 2; ++i) { int R, C; stage_rc(tid * 16 + i * 8192, R, C);
        voffA[0][i] = (unsigned)(R * K + C) * 2u; voffA[1][i] = voffA[0][i]; voffN[0][i] = voffA[0][i]; voffN[1][i] = voffA[0][i]; }
    const size_t kstep = (size_t)(BK * 2);
    const size_t hstep = (size_t)HALF * K * 2;
    const size_t tstep = 2 * hstep;
    const size_t hstepA = GATHER ? 0 : hstep;
    const size_t kstepB = (size_t)BK * 2048 * 4;
    const unsigned ldsw = (unsigned)wid * 1024u;
    const int aoff = lds_byte(wr * 64 + fr, fq * 8);
    const unsigned gvoff = (unsigned)(((tid >> 5) * 2048 + (tid & 31) * 4) * 4);
    unsigned bwoff;
    { const int k0 = tid >> 5, c = 4 * (tid & 31), c5 = c & 31, cp = (c & ~31) + 16 * ((c5 >> 2) & 1) + 4 * (c5 >> 3);
        const int X = ((k0 & 3) << 2) | ((k0 >> 2) & 3); bwoff = (unsigned)(256 * k0 + 16 * ((cp >> 3) ^ X) + 8 * ((cp >> 2) & 1)); }
    const unsigned bwaddr = (unsigned)(size_t)lds + 4 * HTB + bwoff;
    unsigned braddr[2][2];
#pragma unroll
    for (int t = 0; t < 2; ++t) { const int row = 8 * fq + 4 * t + (fr >> 2), X_ = ((row & 3) << 2) | ((row >> 2) & 3), ch = 2 * (2 * wc) + ((lane & 3) >> 1);
        const unsigned o = (unsigned)(256 * row + 16 * (ch ^ X_) + 8 * (lane & 1));
        braddr[t][0] = (unsigned)(size_t)lds + 4 * HTB + o; braddr[t][1] = (unsigned)(size_t)lds + 4 * HTB + (o ^ 32u); }
#define PG8_SA(b, h) (((b) * 2 + (h)) * HTB)
#define PG8_SB(b, h) ((4 + (b) * 2 + (h)) * HTB)
#define PG8_STAGE(bufoff, gbase, voff) do { _Pragma("unroll") for (int _i = 0; _i < 2; ++_i) \
        __builtin_amdgcn_global_load_lds((const unsigned*)((const char*)(gbase) + (voff)[_i]), (LAS unsigned*)(lds + (bufoff) + ldsw + _i * 8192), 16, 0, 0); } while (0)
#define PG8_GOFF(dst, pmv) do { if (GATHER) { _Pragma("unroll") for (int _h = 0; _h < 2; ++_h) _Pragma("unroll") for (int _i = 0; _i < 2; ++_i) { int _R, _C; stage_rc(tid * 16 + _i * 8192, _R, _C); \
        dst[_h][_i] = ((unsigned)src[(pmv) * BM + _h * HALF + _R] * (unsigned)K + (unsigned)_C) * 2u; } } } while (0)
#define PG8_BGL(dst, gbase) do { _Pragma("unroll") for (int _i = 0; _i < 4; ++_i) { const char* _b = (const char*)(gbase) + _i * 131072; \
        asm volatile("global_load_dwordx4 %0, %1, %2" : "=v"(dst[_i]) : "v"(gvoff), "s"(_b) : "memory"); } } while (0)
#define PG8_WAIT_VX(n, r) asm volatile("s_waitcnt vmcnt(" #n ")" : "+v"(r[0]), "+v"(r[1]), "+v"(r[2]), "+v"(r[3]) :: "memory")
#define PG8_BWR(srcv, b, h) do { _Pragma("unroll") for (int _i = 0; _i < 4; ++_i) { u32x2 _w; _w.x = pk2(srcv[_i][0], srcv[_i][1]); _w.y = pk2(srcv[_i][2], srcv[_i][3]); \
        asm volatile("ds_write_b64 %0, %1 offset:%2" :: "v"(bwaddr), "v"(_w), "n"(((b) * 2 + (h)) * HTB + _i * 4096) : "memory"); } } while (0)
#define PG8_LDA(dst, b, h) do { _Pragma("unroll") for (int m = 0; m < 4; ++m) _Pragma("unroll") for (int k = 0; k < 2; ++k) dst[m][k] = *(const LAS bf16x8*)(lds + PG8_SA(b, h) + aoff + m * 2048 + k * 1024); } while (0)
#define PG8_LDB(dst, b, h) do { _Pragma("unroll") for (int n = 0; n < 2; ++n) _Pragma("unroll") for (int k = 0; k < 2; ++k) { s16x4 _lo, _hi; \
            asm volatile("ds_read_b64_tr_b16 %0, %1 offset:%2" : "=v"(_lo) : "v"(braddr[0][n]), "n"(((b) * 2 + (h)) * HTB + k * 8192) : "memory"); \
            asm volatile("ds_read_b64_tr_b16 %0, %1 offset:%2" : "=v"(_hi) : "v"(braddr[1][n]), "n"(((b) * 2 + (h)) * HTB + k * 8192) : "memory"); \
            dst[n][k] = __builtin_shufflevector(_lo, _hi, 0, 1, 2, 3, 4, 5, 6, 7); } } while (0)
#define PG8_WAIT_LB(Bx) asm volatile("s_waitcnt lgkmcnt(0)" : "+v"(Bx[0][0]), "+v"(Bx[0][1]), "+v"(Bx[1][0]), "+v"(Bx[1][1]) :: "memory")
#define PG8_MMA(ai, bj, At, Bt) do { __builtin_amdgcn_s_setprio(1); _Pragma("unroll") for (int m = 0; m < 4; ++m) _Pragma("unroll") for (int n = 0; n < 2; ++n) _Pragma("unroll") for (int k = 0; k < 2; ++k) \
        acc[ai][bj][m][n] = __builtin_amdgcn_mfma_f32_16x16x32_bf16(Bt[n][k], At[m][k], acc[ai][bj][m][n], 0, 0, 0); __builtin_amdgcn_s_setprio(0); } while (0)
#define PG8_WAIT_V(n) asm volatile("s_waitcnt vmcnt(" #n ")" ::: "memory")
#define PG8_WAIT_L(n) asm volatile("s_waitcnt lgkmcnt(" #n ")" ::: "memory")
#define PG8_BAR __builtin_amdgcn_s_barrier()
#define PG8_SCHED __builtin_amdgcn_sched_barrier(0)
#define PG8_BPTR(dst, u) do { const float* _e0 = bs.b0 + (size_t)((u).pn / bs.CT) * 2048 * 2048 + (size_t)(u).pc * bs.cstep; const float* _e1 = bs.b1 + (size_t)((u).pn / bs.CT) * 2048 * 2048 + (size_t)(u).pc * bs.cstep + bs.hoff; \
        dst[0] = (const char*)_e0; dst[1] = (const char*)_e1; } while (0)
    Unit cur, nxt; int ui = 0;
    if (!S.next(0, cur)) return;
    f32x4 acc[2][2][4][2];
#pragma unroll
    for (int a = 0; a < 2; ++a)
#pragma unroll
        for (int b = 0; b < 2; ++b)
#pragma unroll
            for (int m = 0; m < 4; ++m)
#pragma unroll
                for (int n = 0; n < 2; ++n) acc[a][b][m][n] = (f32x4){0.f, 0.f, 0.f, 0.f};
    bf16x8 At[4][2], B0[2][2], B1[2][2];
    f32x4 X[4];
#define PG8_ABASE(u) ((const char*)g.A + (GATHER ? (size_t)0 : (size_t)(u).pm * tstep + ((u).hf == 2 ? hstep : (size_t)0)))
    const char* cA = PG8_ABASE(cur);
    size_t cHA = (HALFU && cur.hf) ? (size_t)0 : hstepA; bool full = !HALFU || cur.hf == 0;
    const char* cB[2]; PG8_BPTR(cB, cur);
    PG8_GOFF(voffA, cur.pm);
    S.a_ready(cur);
    PG8_STAGE(PG8_SA(0, 0), cA, voffA[0]); PG8_STAGE(PG8_SA(0, 1), cA + cHA, voffA[1]);
    PG8_BGL(X, cB[0]); PG8_WAIT_VX(0, X); PG8_BWR(X, 0, 0);
    PG8_BGL(X, cB[1]); PG8_WAIT_VX(0, X); PG8_BWR(X, 0, 1);
    if (wr == 1) PG8_BAR;
    PG8_BGL(X, cB[0] + kstepB); PG8_WAIT_VX(0, X); PG8_BWR(X, 1, 0);
    PG8_WAIT_L(0); PG8_BAR;
    PG8_STAGE(PG8_SA(1, 0), cA + kstep, voffA[0]); PG8_BGL(X, cB[1] + kstepB);
    PG8_BAR;
    for (;;) {
        const bool has_next = S.next(ui + 1, nxt);
        const size_t nHA = (HALFU && has_next) ? (nxt.hf ? (size_t)0 : hstepA) : cHA;
        const char* nA = (has_next && !GATHER) ? PG8_ABASE(nxt) : cA;
        const char* nB[2]; nB[0] = cB[0]; nB[1] = cB[1]; if (has_next) PG8_BPTR(nB, nxt);
        if (GATHER) { if (has_next) PG8_GOFF(voffN, nxt.pm); else {
#pragma unroll
            for (int _h = 0; _h < 2; ++_h)
#pragma unroll
                for (int _i = 0; _i < 2; ++_i) voffN[_h][_i] = voffA[_h][_i]; } }
        for (int t = 0; t < nt; t += 2) {
            const bool last = (t == nt - 2);
            const char* a1 = cA + (size_t)(t + 1) * kstep;
            const char* a2 = last ? nA : cA + (size_t)(t + 2) * kstep;
            const char* a3 = a2 + kstep;
            const char* b20 = last ? nB[0] : cB[0] + (size_t)(t + 2) * kstepB; const char* b21 = last ? nB[1] : cB[1] + (size_t)(t + 2) * kstepB;
            unsigned va2[2][2];
#pragma unroll
            for (int _h = 0; _h < 2; ++_h)
#pragma unroll
                for (int _i = 0; _i < 2; ++_i) va2[_h][_i] = (GATHER && last) ? voffN[_h][_i] : voffA[_h][_i];
            if (last && has_next) S.a_ready(nxt);
            PG8_LDB(B0, 0, 0); PG8_SCHED; PG8_LDA(At, 0, 0); PG8_STAGE(PG8_SA(1, 1), a1 + cHA, voffA[1]);
            PG8_WAIT_L(8); PG8_BAR; PG8_WAIT_LB(B0); PG8_MMA(0, 0, At, B0); PG8_BAR; PG8_SCHED;
            PG8_WAIT_VX(2, X); PG8_BWR(X, 1, 1);
            PG8_LDB(B1, 0, 1); PG8_BGL(X, b20);
            PG8_BAR; PG8_WAIT_LB(B1); PG8_MMA(0, 1, At, B1); PG8_BAR;
            if (full) PG8_LDA(At, 0, 1); PG8_STAGE(PG8_SA(0, 0), a2, va2[0]);
            PG8_BAR; PG8_WAIT_L(0); if (full) PG8_MMA(1, 0, At, B0); PG8_BAR; PG8_SCHED;
            PG8_WAIT_VX(2, X); PG8_BWR(X, 0, 0);
            PG8_BGL(X, b21);
            PG8_WAIT_L(0); PG8_BAR; if (full) PG8_MMA(1, 1, At, B1); PG8_BAR;
            PG8_LDB(B0, 1, 0); PG8_SCHED; PG8_LDA(At, 1, 0); PG8_STAGE(PG8_SA(0, 1), a2 + (last ? nHA : cHA), va2[1]);
            PG8_WAIT_L(8); PG8_BAR; PG8_WAIT_LB(B0); PG8_MMA(0, 0, At, B0); PG8_BAR; PG8_SCHED;
            PG8_WAIT_VX(2, X); PG8_BWR(X, 0, 1);
            PG8_LDB(B1, 1, 1); PG8_BGL(X, b20 + kstepB);
            PG8_BAR; PG8_WAIT_LB(B1); PG8_MMA(0, 1, At, B1); PG8_BAR;
            if (full) PG8_LDA(At, 1, 1); PG8_STAGE(PG8_SA(1, 0), a3, va2[0]);
            PG8_BAR; PG8_WAIT_L(0); if (full) PG8_MMA(1, 0, At, B0); PG8_BAR; PG8_SCHED;
            PG8_WAIT_VX(2, X); PG8_BWR(X, 1, 0);
            PG8_BGL(X, b21 + kstepB);
            PG8_WAIT_L(0); PG8_BAR; if (full) PG8_MMA(1, 1, At, B1); PG8_BAR;
        }
        { int tz = threadIdx.x; asm volatile("" : "+v"(tz)); const int wz = __builtin_amdgcn_readfirstlane(tz >> 6); E(acc, cur, wz >> 2, wz & 3, tz & 15, (tz & 63) >> 4); } S.done(cur);
        if (!has_next) break;
#pragma unroll
        for (int a = 0; a < 2; ++a)
#pragma unroll
            for (int b = 0; b < 2; ++b)
#pragma unroll
                for (int m = 0; m < 4; ++m)
#pragma unroll
                    for (int n = 0; n < 2; ++n) acc[a][b][m][n] = (f32x4){0.f, 0.f, 0.f, 0.f};
        cur = nxt; cA = nA; cB[0] = nB[0]; cB[1] = nB[1]; cHA = nHA; full = !HALFU || cur.hf == 0; ++ui;
        if (GATHER) {
#pragma unroll
            for (int _h = 0; _h < 2; ++_h)
#pragma unroll
                for (int _i = 0; _i < 2; ++_i) voffA[_h][_i] = voffN[_h][_i]; }
    }
    PG8_WAIT_V(0);
    if (wr == 0) PG8_BAR;
    PG8_BAR;
#undef PG8_SA
#undef PG8_SB
#undef PG8_STAGE
#undef PG8_GOFF
#undef PG8_ABASE
#undef PG8_BGL
#undef PG8_WAIT_VX
#undef PG8_BWR
#undef PG8_LDA
#undef PG8_LDB
#undef PG8_WAIT_LB
#undef PG8_MMA
#undef PG8_WAIT_V
#undef PG8_WAIT_L
#undef PG8_BAR
#undef PG8_SCHED
#undef PG8_BPTR
}

struct EpiStore {
    static constexpr bool PERM = true;
    bf16_t* O; int ldc;
    __device__ __forceinline__ void operator()(const f32x4 (&acc)[2][2][4][2], const Unit& u, int wr, int wc, int fr, int fq) const {
        const int row0 = u.pm * BM + (u.hf == 2 ? HALF : 0) + wr * 64 + fr, col0 = u.pc * BM + wc * 32 + 8 * fq;
#pragma unroll
        for (int ai = 0; ai < 2; ++ai) if (ai == 0 || u.hf == 0)
#pragma unroll
            for (int m = 0; m < 4; ++m) { bf16_t* rowp = O + (size_t)(row0 + ai * HALF + m * 16) * ldc + col0;
#pragma unroll
                for (int bj = 0; bj < 2; ++bj) { const f32x4 v0 = acc[ai][bj][m][0], v1 = acc[ai][bj][m][1];
                    u32x4 w; w.x = pk2(v0[0], v0[1]); w.y = pk2(v0[2], v0[3]); w.z = pk2(v1[0], v1[1]); w.w = pk2(v1[2], v1[3]);
                    *(u32x4*)(rowp + bj * HALF) = w; } }
    }
};
struct EpiSiluMul {
    static constexpr bool PERM = true;
    bf16_t* O;
    __device__ __forceinline__ void operator()(const f32x4 (&acc)[2][2][4][2], const Unit& u, int wr, int wc, int fr, int fq) const {
        const int row0 = u.pm * BM + (u.hf == 2 ? HALF : 0) + wr * 64 + fr, col0 = u.pc * HALF + wc * 32 + 8 * fq;
#pragma unroll
        for (int ai = 0; ai < 2; ++ai) if (ai == 0 || u.hf == 0)
#pragma unroll
            for (int m = 0; m < 4; ++m) { bf16_t* rowp = O + (size_t)(row0 + ai * HALF + m * 16) * D + col0;
                float h[8];
#pragma unroll
                for (int n = 0; n < 2; ++n)
#pragma unroll
                    for (int j = 0; j < 4; ++j) { const float gt = acc[ai][0][m][n][j], up = acc[ai][1][m][n][j]; h[n * 4 + j] = gt * __builtin_amdgcn_rcpf(1.f + __expf(-gt)) * up; }
                u32x4 w; w.x = pk2(h[0], h[1]); w.y = pk2(h[2], h[3]); w.z = pk2(h[4], h[5]); w.w = pk2(h[6], h[7]);
                *(u32x4*)rowp = w; }
    }
};
template <bool XIN_BF16>
struct EpiResid {
    static constexpr bool PERM = true;
    const float* xinLat; const float* xinCtx; bf16_t* X1; const float* g1;
    __device__ __forceinline__ void operator()(const f32x4 (&acc)[2][2][4][2], const Unit& u, int wr, int wc, int fr, int fq) const {
        const int row0 = u.pm * BM + (u.hf == 2 ? HALF : 0) + wr * 64 + fr, col0 = u.pc * BM + wc * 32 + 8 * fq;
        const int mrow = u.pm < 64 ? (u.pm >> 4) : 4;
        f32x4 gv[2][2];
#pragma unroll
        for (int bj = 0; bj < 2; ++bj)
#pragma unroll
            for (int n = 0; n < 2; ++n) gv[bj][n] = *(const f32x4*)(g1 + (size_t)mrow * 12288 + col0 + bj * HALF + 4 * n);
#pragma unroll
        for (int ai = 0; ai < 2; ++ai) if (ai == 0 || u.hf == 0)
#pragma unroll
            for (int m = 0; m < 4; ++m) { const int row = row0 + ai * HALF + m * 16;
                bf16_t* orow = X1 + (size_t)row * D + col0;
#pragma unroll
                for (int bj = 0; bj < 2; ++bj) { f32x4 x0, x1;
                    if (XIN_BF16) { const u32x4 w = *(const u32x4*)(orow + bj * HALF); x0 = (f32x4){bflo(w.x), bfhi(w.x), bflo(w.y), bfhi(w.y)}; x1 = (f32x4){bflo(w.z), bfhi(w.z), bflo(w.w), bfhi(w.w)}; }
                    else { const float* xr = (u.pm < 64 ? xinLat + (size_t)row * D : xinCtx + (size_t)(row - M_LAT) * D) + col0 + bj * HALF; x0 = *(const f32x4*)xr; x1 = *(const f32x4*)(xr + 4); }
                    const f32x4 v0 = x0 + gv[bj][0] * acc[ai][bj][m][0], v1 = x1 + gv[bj][1] * acc[ai][bj][m][1];
                    u32x4 w; w.x = pk2(v0[0], v0[1]); w.y = pk2(v0[2], v0[3]); w.z = pk2(v1[0], v1[1]); w.w = pk2(v1[2], v1[3]);
                    *(u32x4*)(orow + bj * HALF) = w; } }
    }
};
}

struct Args { const float* in[26]; float* out; unsigned char* ws; int lo, hi; };
enum { I_X = 0, I_C, I_CTX, I_CCTX, I_ADAW, I_ADAB, I_NMIX, I_NFFN, I_NFIN, I_EVIN, I_EVOUT, I_GAMMA, I_RETN, I_GMLPN, I_GMLPW, I_GMLPB,
       I_ODIN, I_ODOUT, I_RPB, I_GLAWUP, I_GLABUP, I_GLAN, I_ROUTER, I_WGATE, I_WUP, I_WDOWN };

__device__ __forceinline__ void phase_prologue(const Args& a, LAS unsigned char* lds) {
    const int tid = threadIdx.x;
    if (blockIdx.x == gridDim.x - 1) {
        float* rc = (float*)(a.ws + WS_ROT); float* rs = rc + 2048;
        for (int i = tid; i < 2048; i += 512) { const int pos = i >> 5, f = i & 31; const float freq = exp2f(-(float)f * 0.41524101186092029f); const float ang = (float)pos * freq;
            rc[i] = __cosf(ang); rs[i] = __sinf(ang); }
    }
    { bf16_t* wb = (bf16_t*)(a.ws + WS_GMW);
        for (int i = blockIdx.x * 512 + tid; i < 8 * 128 * 128 / 2; i += gridDim.x * 512) { const f32x2 v = *(const f32x2*)(a.in[I_GMLPW] + 2 * i); ((unsigned*)wb)[i] = pk2(v[0], v[1]); } }
    LAS float* sc = (LAS float*)lds;
    LAS float* red = (LAS float*)(lds + 40960);
    float* MOD = (float*)(a.ws + WS_MOD);
    if ((int)blockIdx.x < 192) {
        for (int i = tid; i < 5 * 2048; i += 512) { const int r = i >> 11, k = i & 2047; const float v = r < 4 ? a.in[I_C][r * 2048 + k] : a.in[I_CCTX][k]; sc[i] = v / (1.f + expf(-v)); }
        __syncthreads();
        const int u = blockIdx.x, l = u / 96, cb = u % 96, cq = tid & 31, kq = tid >> 5;
        const float* w = a.in[I_ADAW] + (size_t)l * 2048 * 12288 + cb * 128 + cq * 4;
        f32x4 acc[5];
#pragma unroll
        for (int r = 0; r < 5; ++r) acc[r] = (f32x4){0.f, 0.f, 0.f, 0.f};
        for (int j0 = 0; j0 < 128; j0 += 16) {
            f32x4 wv[16];
#pragma unroll
            for (int j = 0; j < 16; ++j) wv[j] = *(const f32x4*)(w + (size_t)(kq + 16 * (j0 + j)) * 12288);
            __builtin_amdgcn_sched_barrier(0);
#pragma unroll
            for (int j = 0; j < 16; ++j) { const int k = kq + 16 * (j0 + j);
#pragma unroll
                for (int r = 0; r < 5; ++r) acc[r] += sc[r * 2048 + k] * wv[j]; }
        }
#pragma unroll
        for (int r = 0; r < 5; ++r) *(LAS f32x4*)(red + (kq * 5 + r) * 128 + cq * 4) = acc[r];
        __syncthreads();
        for (int o = tid; o < 640; o += 512) { const int r = o >> 7, cc = o & 127; float s = 0.f;
#pragma unroll
            for (int q = 0; q < 16; ++q) s += red[(q * 5 + r) * 128 + cc];
            MOD[(size_t)(l * 5 + r) * 12288 + cb * 128 + cc] = s + a.in[I_ADAB][l * 12288 + cb * 128 + cc]; }
    }
    LAS float* tile = (LAS float*)lds;
    constexpr int CJ0 = 16 * 48, CJ1 = 16 * 16, CJ2 = 16 * 50, CJ3 = 16 * 16, CJM = 32 * 256;
    constexpr int CTOT = CJ0 + CJ1 + CJ2 + CJ3 + 2 * CJM;
    __syncthreads();
    unsigned* cq_head = (unsigned*)(a.ws + WS_CTL) + 8192 + 768;
    volatile LAS int* qs = (volatile LAS int*)(lds + 128 * 129 * 4);
    int pend = 0, it = 0;
    if (tid == 0) { qs[0] = (int)xb_add(cq_head, 1u); pend = (int)xb_add(cq_head, 1u); }
    __syncthreads();
    for (int u = qs[0]; u < CTOT; u = qs[it & 1]) {
        int r = u; const float* src; int ldn, nvalid, NT, mode = 0; bf16_t* dst;
        if (r < CJ0) { src = a.in[I_EVIN]; ldn = 6144; nvalid = 6144; NT = 48; dst = (bf16_t*)(a.ws + WS_WIN0); }
        else if ((r -= CJ0) < CJ1) { src = a.in[I_EVOUT]; ldn = 2048; nvalid = 2048; NT = 16; dst = (bf16_t*)(a.ws + WS_WOUT0); }
        else if ((r -= CJ1) < CJ2) { src = a.in[I_ODIN]; ldn = 6176; nvalid = 6176; NT = 50; dst = (bf16_t*)(a.ws + WS_WIN1); }
        else if ((r -= CJ2) < CJ3) { src = a.in[I_ODOUT]; ldn = 2048; nvalid = 2048; NT = 16; dst = (bf16_t*)(a.ws + WS_WOUT1); }
        else { r -= CJ3; const int which = r / CJM; r -= which * CJM; const int mtx = r >> 8; r &= 255; ldn = 2048; nvalid = 2048; NT = 16;
            if (which == 0) { src = a.in[I_WGATE] + (size_t)mtx * 2048 * 2048; dst = (bf16_t*)(a.ws + WS_WGU) + (size_t)mtx * 4096 * 2048; mode = 1; }
            else if (which == 1) { src = a.in[I_WUP] + (size_t)mtx * 2048 * 2048; dst = (bf16_t*)(a.ws + WS_WGU) + (size_t)mtx * 4096 * 2048; mode = 2; }
            else { src = a.in[I_WDOWN] + (size_t)mtx * 2048 * 2048; dst = (bf16_t*)(a.ws + WS_WDN) + (size_t)mtx * 2048 * 2048; } }
        const int kt = r / NT, ntl = r % NT, k0 = kt * 128, n0 = ntl * 128;
        const int drow0 = mode == 0 ? n0 : (ntl * 256 + (mode == 2 ? 128 : 0));
        f32x4 v[8];
#pragma unroll
        for (int i = 0; i < 8; ++i) { const int id = tid + 512 * i, row = id >> 5, c4 = id & 31, n = n0 + c4 * 4;
            v[i] = (f32x4){0.f, 0.f, 0.f, 0.f};
            if (n < nvalid) v[i] = *(const f32x4*)(src + (size_t)(k0 + row) * ldn + n); }
#pragma unroll
        for (int i = 0; i < 8; ++i) { const int id = tid + 512 * i, row = id >> 5, c4 = id & 31;
            LAS float* tp = tile + row * 129 + c4 * 4; tp[0] = v[i][0]; tp[1] = v[i][1]; tp[2] = v[i][2]; tp[3] = v[i][3]; }
        lds_barrier();
#pragma unroll
        for (int i = 0; i < 4; ++i) { const int piece = tid + 512 * i, nl = piece >> 4, kg = piece & 15; const LAS float* s = tile + (kg * 8) * 129 + nl;
            u32x4 o; o.x = pk2(s[0], s[129]); o.y = pk2(s[258], s[387]); o.z = pk2(s[516], s[645]); o.w = pk2(s[774], s[903]);
            *(u32x4*)(dst + (size_t)(drow0 + nl) * 2048 + k0 + kg * 8) = o; }
        ++it;
        if (tid == 0) { qs[it & 1] = pend; pend = (int)xb_add(cq_head, 1u); }
        lds_barrier();
    }
}

__device__ __forceinline__ void phase_modnorm(const float* srcLat, const float* srcCtx, int nrows, const float* gain, const float* modl, int sh_off, int sc_off, bf16_t* Hb) {
    const int tid = threadIdx.x, lane = tid & 63, wave = tid >> 6;
    const int RPW = (nrows + (int)gridDim.x - 1) / (int)gridDim.x, rb = blockIdx.x * RPW, re = min(rb + RPW, nrows);
    f32x4 nv[4][2];
    const int r0 = rb + wave;
    if (r0 < re) { const float* xr = r0 < M_LAT ? srcLat + (size_t)r0 * D : srcCtx + (size_t)(r0 - M_LAT) * D;
#pragma unroll
        for (int j = 0; j < 4; ++j) { nv[j][0] = *(const f32x4*)(xr + 8 * (lane + 64 * j)); nv[j][1] = *(const f32x4*)(xr + 8 * (lane + 64 * j) + 4); } }
    f32x4 A[4][2], S[4][2]; int mcur = -1;
    for (int r = r0; r < re; r += 8) {
        const int mrow = r < M_LAT ? (r >> 12) : 4;
        if (mrow != mcur) { mcur = mrow; const float* mr = modl + (size_t)mrow * 12288;
#pragma unroll
            for (int j = 0; j < 4; ++j)
#pragma unroll
                for (int t = 0; t < 2; ++t) { const int k = 8 * (lane + 64 * j) + 4 * t; A[j][t] = *(const f32x4*)(gain + k) * (*(const f32x4*)(mr + sc_off + k) + 1.f); S[j][t] = *(const f32x4*)(mr + sh_off + k); } }
        f32x4 v[4][2]; float ss = 0.f;
#pragma unroll
        for (int j = 0; j < 4; ++j)
#pragma unroll
            for (int t = 0; t < 2; ++t) { v[j][t] = nv[j][t]; ss += (v[j][t][0] * v[j][t][0] + v[j][t][1] * v[j][t][1]) + (v[j][t][2] * v[j][t][2] + v[j][t][3] * v[j][t][3]); }
        const int rn = r + 8;
        if (rn < re) { const float* xn = rn < M_LAT ? srcLat + (size_t)rn * D : srcCtx + (size_t)(rn - M_LAT) * D;
#pragma unroll
            for (int j = 0; j < 4; ++j) { nv[j][0] = *(const f32x4*)(xn + 8 * (lane + 64 * j)); nv[j][1] = *(const f32x4*)(xn + 8 * (lane + 64 * j) + 4); } }
        const float rstd = rsqrtf(wave_sum(ss) * (1.f / D) + EPS);
        bf16_t* orow = Hb + (size_t)r * D;
#pragma unroll
        for (int j = 0; j < 4; ++j) { const f32x4 h0 = v[j][0] * rstd * A[j][0] + S[j][0], h1 = v[j][1] * rstd * A[j][1] + S[j][1];
            u32x4 w; w.x = pk2(h0[0], h0[1]); w.y = pk2(h0[2], h0[3]); w.z = pk2(h1[0], h1[1]); w.w = pk2(h1[2], h1[3]);
            *(u32x4*)(orow + 8 * (lane + 64 * j)) = w; }
    }
}

constexpr int RT_HRS = 4096 + 16, RT_WRS = 4096 + 16;
constexpr int RT_H = 0, RT_W = 16 * RT_HRS, RT_RED = RT_W + 16 * RT_WRS, RT_END = RT_RED + 8 * 1024;
static_assert(RT_END <= LDS_BARW, "router LDS map");
__device__ __forceinline__ void phase_modnorm_router(const bf16_t* X1, int nrows, const float* gain, const float* modl, int sh_off, int sc_off,
                                                     bf16_t* Hb, const float* router_w, float* aff, LAS unsigned char* lds) {
    const int tid = threadIdx.x, lane = tid & 63, wv = __builtin_amdgcn_readfirstlane(tid >> 6);
    const int l15 = lane & 15, q = lane >> 4;
    __syncthreads();
#pragma unroll 4
    for (int i4 = tid; i4 < 2048 * 4; i4 += 512) { const int k = i4 >> 2, e0 = 4 * (i4 & 3); const f32x4 w = *(const f32x4*)(router_w + 4 * i4);
#pragma unroll
        for (int c = 0; c < 4; ++c) *(LAS bf16_t*)(lds + RT_W + (e0 + c) * RT_WRS + k * 2) = (bf16_t)f2bf(w[c]); }
    __syncthreads();
    const int ngroups = nrows / 16;
    u32x4 nxr[2][4];
    const int gb = (int)(((long)blockIdx.x * ngroups) / gridDim.x), ge = (int)(((long)(blockIdx.x + 1) * ngroups) / gridDim.x);
    f32x4 Am[4][2], Sm[4][2]; int mcur = -1;
    if (gb < ge) {
#pragma unroll
        for (int rr = 0; rr < 2; ++rr)
#pragma unroll
            for (int j = 0; j < 4; ++j) nxr[rr][j] = *(const u32x4*)(X1 + (size_t)(gb * 16 + 2 * wv + rr) * D + 8 * (lane + 64 * j)); }
    for (int grp = gb; grp < ge; ++grp) {
        u32x4 cxr[2][4];
#pragma unroll
        for (int rr = 0; rr < 2; ++rr)
#pragma unroll
            for (int j = 0; j < 4; ++j) cxr[rr][j] = nxr[rr][j];
        if (grp + 1 < ge) {
#pragma unroll
            for (int rr = 0; rr < 2; ++rr)
#pragma unroll
                for (int j = 0; j < 4; ++j) nxr[rr][j] = *(const u32x4*)(X1 + (size_t)((grp + 1) * 16 + 2 * wv + rr) * D + 8 * (lane + 64 * j)); }
        { const int mrow = (grp * 16) < M_LAT ? ((grp * 16) >> 12) : 4;
            if (mrow != mcur) { mcur = mrow; const float* mr = modl + (size_t)mrow * 12288;
#pragma unroll
                for (int j = 0; j < 4; ++j)
#pragma unroll
                    for (int t2 = 0; t2 < 2; ++t2) { const int k = 8 * (lane + 64 * j) + 4 * t2; Am[j][t2] = *(const f32x4*)(gain + k) * (*(const f32x4*)(mr + sc_off + k) + 1.f); Sm[j][t2] = *(const f32x4*)(mr + sh_off + k); } } }
#pragma unroll
        for (int rr = 0; rr < 2; ++rr) {
            const int lr = 2 * wv + rr, r = grp * 16 + lr;
            f32x4 v[4][2]; float ss = 0.f;
#pragma unroll
            for (int j = 0; j < 4; ++j) { const u32x4 w = cxr[rr][j];
                v[j][0] = (f32x4){bflo(w.x), bfhi(w.x), bflo(w.y), bfhi(w.y)}; v[j][1] = (f32x4){bflo(w.z), bfhi(w.z), bflo(w.w), bfhi(w.w)};
#pragma unroll
                for (int t2 = 0; t2 < 2; ++t2) ss += (v[j][t2][0] * v[j][t2][0] + v[j][t2][1] * v[j][t2][1]) + (v[j][t2][2] * v[j][t2][2] + v[j][t2][3] * v[j][t2][3]); }
            const float rstd = rsqrtf(wave_sum(ss) * (1.f / D) + EPS);
            bf16_t* orow = Hb + (size_t)r * D;
#pragma unroll
            for (int j = 0; j < 4; ++j) { const int k = 8 * (lane + 64 * j);
                f32x4 hv[2];
#pragma unroll
                for (int t2 = 0; t2 < 2; ++t2) hv[t2] = v[j][t2] * rstd * Am[j][t2] + Sm[j][t2];
                u32x4 w; w.x = pk2(hv[0][0], hv[0][1]); w.y = pk2(hv[0][2], hv[0][3]); w.z = pk2(hv[1][0], hv[1][1]); w.w = pk2(hv[1][2], hv[1][3]);
                *(u32x4*)(orow + k) = w; *(LAS u32x4*)(lds + RT_H + lr * RT_HRS + k * 2) = w; }
        }
        lds_barrier();
        f32x4 acc = (f32x4){0.f, 0.f, 0.f, 0.f};
#pragma unroll
        for (int kk = 0; kk < 8; ++kk) { const int kb = (256 * wv + 32 * kk + 8 * q) * 2;
            const bf16x8 af = *(const LAS bf16x8*)(lds + RT_H + l15 * RT_HRS + kb), bfr = *(const LAS bf16x8*)(lds + RT_W + l15 * RT_WRS + kb);
            acc = __builtin_amdgcn_mfma_f32_16x16x32_bf16(af, bfr, acc, 0, 0, 0); }
        { LAS float* red = (LAS float*)(lds + RT_RED) + wv * 256;
#pragma unroll
            for (int rg = 0; rg < 4; ++rg) red[(4 * q + rg) * 16 + l15] = acc[rg]; }
        lds_barrier();
        if (tid < 256) { const int row = tid >> 4, e = tid & 15; float lg = 0.f;
#pragma unroll
            for (int w = 0; w < 8; ++w) lg += ((const LAS float*)(lds + RT_RED))[w * 256 + tid];
            float mx = lg;
#pragma unroll
            for (int o = 1; o < 16; o <<= 1) mx = fmaxf(mx, __shfl_xor(mx, o));
            const float ex = __expf(lg - mx); float den = ex;
#pragma unroll
            for (int o = 1; o < 16; o <<= 1) den += __shfl_xor(den, o);
            const float p = ex / den; const int r = grp * 16 + row;
            if (r < M_LAT) aff[((size_t)((r >> 12) * NE + e)) * T + (r & 4095)] = p;
            else { const int rc = r - M_LAT; aff[(size_t)NB * NE * T + ((size_t)((rc >> 8) * NE + e)) * CL + (rc & 255)] = p; } }
        lds_barrier();
    }
}

__device__ __forceinline__ int block_excl_scan(int v, LAS int* wsum, int lane, int wave, int& total) {
    int incl = v;
#pragma unroll
    for (int o = 1; o < 64; o <<= 1) { const int t = __shfl_up(incl, o); if (lane >= o) incl += t; }
    __syncthreads();
    if (lane == 63) wsum[wave] = incl;
    __syncthreads();
    int base = 0, tot = 0;
#pragma unroll
    for (int w = 0; w < 8; ++w) { const int s = wsum[w]; tot += s; base += (w < wave) ? s : 0; }
    total = tot;
    return base + incl - v;
}
__device__ __forceinline__ void phase_topk(const float* aff, int* SRC, float* GATE, int* INV, int RPE, bool with_ctx, LAS unsigned char* lds) {
    const int tid = threadIdx.x, lane = tid & 63, wave = tid >> 6;
    LAS int* wsum = (LAS int*)lds;
    LAS int* cnts = (LAS int*)(lds + 64);
    const int nunits = with_ctx ? 128 : 64;
    for (int u = blockIdx.x; u < nunits; u += gridDim.x) {
        const int kind = u >> 6, b = (u >> 4) & 3, e = u & 15;
        const int Tn = kind ? CL : T, cap = Tn / 8;
        const float* av = aff + (kind ? (size_t)NB * NE * T + (size_t)(b * NE + e) * CL : (size_t)(b * NE + e) * T);
        unsigned vb[8];
#pragma unroll
        for (int j = 0; j < 8; ++j) { const int t = tid * 8 + j; vb[j] = t < Tn ? __float_as_uint(av[t]) : 0u; }
        unsigned thr = 0u;
        for (int bit = 30; bit >= 0; --bit) {
            const unsigned cand = thr | (1u << bit);
            int c = 0;
#pragma unroll
            for (int j = 0; j < 8; ++j) c += (vb[j] >= cand) ? 1 : 0;
#pragma unroll
            for (int o = 1; o < 64; o <<= 1) c += __shfl_xor(c, o);
            LAS int* cb = cnts + (bit & 1) * 8;
            if (lane == 0) cb[wave] = c;
            __syncthreads();
            int tot = 0;
#pragma unroll
            for (int w = 0; w < 8; ++w) tot += cb[w];
            if (tot >= cap) thr = cand;
        }
        int ngt_l = 0, neq_l = 0;
#pragma unroll
        for (int j = 0; j < 8; ++j) { ngt_l += (vb[j] > thr) ? 1 : 0; neq_l += (vb[j] == thr) ? 1 : 0; }
        int ngt_tot, neq_tot;
        (void)block_excl_scan(ngt_l, wsum, lane, wave, ngt_tot);
        const int eq_base = block_excl_scan(neq_l, wsum, lane, wave, neq_tot);
        const int need_eq = cap - ngt_tot;
        int sel_l = 0, eqr = eq_base; unsigned selmask = 0u;
#pragma unroll
        for (int j = 0; j < 8; ++j) { bool s = vb[j] > thr; if (vb[j] == thr) { s = eqr < need_eq; ++eqr; } if (vb[j] == 0u) s = false; selmask |= s ? (1u << j) : 0u; sel_l += s ? 1 : 0; }
        int sel_tot;
        int slot = block_excl_scan(sel_l, wsum, lane, wave, sel_tot);
        const int gbase = e * RPE + (kind ? 2048 + b * 32 : b * 512);
        const int rbase = kind ? M_LAT + b * CL : b * T;
#pragma unroll
        for (int j = 0; j < 8; ++j) { const int t = tid * 8 + j;
            if (t < Tn) { int g = -1;
                if (selmask & (1u << j)) { g = gbase + slot; ++slot; SRC[g] = rbase + t; GATE[g] = __uint_as_float(vb[j]); }
                INV[(size_t)(rbase + t) * NE + e] = g; } }
        if (kind == 1 && b == 0 && tid < 128) { SRC[e * RPE + 2176 + tid] = 0; GATE[e * RPE + 2176 + tid] = 0.f; }
        __syncthreads();
    }
}

template <bool LAST>
__device__ __forceinline__ void phase_moe_combine(bf16_t* X1, const bf16_t* Ye, const int* INV, const float* GATE, const float* g2  , int nrows,
                                                  const float* gain, const float* modn, bf16_t* Hb, float* out) {
    const int lane = threadIdx.x & 63, wave = threadIdx.x >> 6;
    const int gw = blockIdx.x * 8 + wave, NGW = gridDim.x * 8;
    u32x4 inv[4], nx[4];
    if (gw < nrows) {
#pragma unroll
        for (int i = 0; i < 4; ++i) { inv[i] = *(const u32x4*)(INV + (size_t)gw * NE + 4 * i); nx[i] = *(const u32x4*)(X1 + (size_t)gw * D + 8 * (lane + 64 * i)); } }
    for (int r = gw; r < nrows; r += NGW) {
        const int mrow = r < M_LAT ? (r >> 12) : 4;
        const unsigned sl[16] = {inv[0].x, inv[0].y, inv[0].z, inv[0].w, inv[1].x, inv[1].y, inv[1].z, inv[1].w, inv[2].x, inv[2].y, inv[2].z, inv[2].w, inv[3].x, inv[3].y, inv[3].z, inv[3].w};
        if (r + NGW < nrows) {
#pragma unroll
            for (int i = 0; i < 4; ++i) inv[i] = *(const u32x4*)(INV + (size_t)(r + NGW) * NE + 4 * i); }
        f32x4 acc[4][2];
#pragma unroll
        for (int j = 0; j < 4; ++j) { acc[j][0] = (f32x4){0.f, 0.f, 0.f, 0.f}; acc[j][1] = (f32x4){0.f, 0.f, 0.f, 0.f}; }
#pragma unroll
        for (int e = 0; e < NE; ++e) {
            const int s = __builtin_amdgcn_readfirstlane((int)sl[e]);
            if (s >= 0) { const float gt = GATE[s]; const bf16_t* yr = Ye + (size_t)s * D;
#pragma unroll
                for (int j = 0; j < 4; ++j) { const u32x4 w = *(const u32x4*)(yr + 8 * (lane + 64 * j));
                    acc[j][0] += (f32x4){bflo(w.x), bfhi(w.x), bflo(w.y), bfhi(w.y)} * gt; acc[j][1] += (f32x4){bflo(w.z), bfhi(w.z), bflo(w.w), bfhi(w.w)} * gt; } }
        }
        bf16_t* xr = X1 + (size_t)r * D; const float* gr = g2 + (size_t)mrow * 12288;
        u32x4 xw_[4];
#pragma unroll
        for (int j = 0; j < 4; ++j) xw_[j] = nx[j];
        if (r + NGW < nrows) {
#pragma unroll
            for (int j = 0; j < 4; ++j) nx[j] = *(const u32x4*)(X1 + (size_t)(r + NGW) * D + 8 * (lane + 64 * j)); }
        f32x4 v[4][2]; float ss = 0.f;
#pragma unroll
        for (int j = 0; j < 4; ++j) { const int k = 8 * (lane + 64 * j); const u32x4 w = xw_[j];
            v[j][0] = (f32x4){bflo(w.x), bfhi(w.x), bflo(w.y), bfhi(w.y)} + *(const f32x4*)(gr + k) * acc[j][0];
            v[j][1] = (f32x4){bflo(w.z), bfhi(w.z), bflo(w.w), bfhi(w.w)} + *(const f32x4*)(gr + k + 4) * acc[j][1];
#pragma unroll
            for (int t2 = 0; t2 < 2; ++t2) ss += (v[j][t2][0] * v[j][t2][0] + v[j][t2][1] * v[j][t2][1]) + (v[j][t2][2] * v[j][t2][2] + v[j][t2][3] * v[j][t2][3]); }
        const float rstd = rsqrtf(wave_sum(ss) * (1.f / D) + EPS);
        if (LAST) {
#pragma unroll
            for (int j = 0; j < 4; ++j) { const int k = 8 * (lane + 64 * j);
                *(f32x4*)(out + (size_t)r * D + k) = v[j][0] * rstd * *(const f32x4*)(gain + k); *(f32x4*)(out + (size_t)r * D + k + 4) = v[j][1] * rstd * *(const f32x4*)(gain + k + 4); }
        } else {
            const float* mr = modn + (size_t)mrow * 12288;
#pragma unroll
            for (int j = 0; j < 4; ++j) { const int k = 8 * (lane + 64 * j);
                u32x4 xw; xw.x = pk2(v[j][0][0], v[j][0][1]); xw.y = pk2(v[j][0][2], v[j][0][3]); xw.z = pk2(v[j][1][0], v[j][1][1]); xw.w = pk2(v[j][1][2], v[j][1][3]);
                *(u32x4*)(xr + k) = xw;
                f32x4 h[2];
#pragma unroll
                for (int t2 = 0; t2 < 2; ++t2) h[t2] = v[j][t2] * rstd * *(const f32x4*)(gain + k + 4 * t2) * (*(const f32x4*)(mr + D + k + 4 * t2) + 1.f) + *(const f32x4*)(mr + k + 4 * t2);
                u32x4 w; w.x = pk2(h[0][0], h[0][1]); w.y = pk2(h[0][2], h[0][3]); w.z = pk2(h[1][0], h[1][1]); w.w = pk2(h[1][2], h[1][3]);
                *(u32x4*)(Hb + (size_t)r * D + k) = w; }
        }
    }
}

__device__ __forceinline__ void phase_head_combine_bf16(const bf16_t* Of, const bf16_t* Ob, const bf16_t* P, int ldp, int gcol, const float* gain, bf16_t* AO, int ocol, int nrows) {
    const int lane = threadIdx.x & 63, wave = threadIdx.x >> 6;
    const int gw = blockIdx.x * 8 + wave, NGW = gridDim.x * 8;
    const int hc = (lane >> 3) * 128 + (lane & 7) * 16;
    u32x4 nf0, nf1, nb0, nb1, ng0, ng1;
#define HC_LOAD(rr) do { const u32x4* pf_ = (const u32x4*)(Of + (size_t)(rr) * 1024 + hc); const u32x4* pb_ = (const u32x4*)(Ob + (size_t)(rr) * 1024 + hc); const u32x4* gp_ = (const u32x4*)(P + (size_t)(rr) * ldp + gcol + hc); \
        nf0 = pf_[0]; nf1 = pf_[1]; nb0 = pb_[0]; nb1 = pb_[1]; ng0 = gp_[0]; ng1 = gp_[1]; } while (0)
    f32x4 gnv[4];
#pragma unroll
    for (int i = 0; i < 4; ++i) gnv[i] = *(const f32x4*)(gain + hc + 4 * i);
    if (gw < nrows) HC_LOAD(gw);
    for (int r = gw; r < nrows; r += NGW) {
        const unsigned fw[8] = {nf0.x, nf0.y, nf0.z, nf0.w, nf1.x, nf1.y, nf1.z, nf1.w}, bw[8] = {nb0.x, nb0.y, nb0.z, nb0.w, nb1.x, nb1.y, nb1.z, nb1.w};
        const unsigned gw_[8] = {ng0.x, ng0.y, ng0.z, ng0.w, ng1.x, ng1.y, ng1.z, ng1.w};
        if (r + NGW < nrows) HC_LOAD(r + NGW);
        f32x4 o[4]; float ss = 0.f;
#pragma unroll
        for (int i = 0; i < 4; ++i) { o[i] = (f32x4){bflo(fw[2 * i]) + bflo(bw[2 * i]), bfhi(fw[2 * i]) + bfhi(bw[2 * i]), bflo(fw[2 * i + 1]) + bflo(bw[2 * i + 1]), bfhi(fw[2 * i + 1]) + bfhi(bw[2 * i + 1])};
            ss += (o[i][0] * o[i][0] + o[i][1] * o[i][1]) + (o[i][2] * o[i][2] + o[i][3] * o[i][3]); }
        ss += __shfl_xor(ss, 1); ss += __shfl_xor(ss, 2); ss += __shfl_xor(ss, 4);
        const float rstd = rsqrtf(ss * (1.f / 128.f) + EPS);
        unsigned ow[8];
#pragma unroll
        for (int i = 0; i < 4; ++i) { const f32x4 gn = gnv[i];
            const float a0 = o[i][0] * rstd * gn[0] * silu_f(bflo(gw_[2 * i])), a1 = o[i][1] * rstd * gn[1] * silu_f(bfhi(gw_[2 * i]));
            const float a2 = o[i][2] * rstd * gn[2] * silu_f(bflo(gw_[2 * i + 1])), a3 = o[i][3] * rstd * gn[3] * silu_f(bfhi(gw_[2 * i + 1]));
            ow[2 * i] = pk2(a0, a1); ow[2 * i + 1] = pk2(a2, a3); }
        u32x4* op = (u32x4*)(AO + (size_t)r * D + ocol + hc);
        op[0] = (u32x4){ow[0], ow[1], ow[2], ow[3]}; op[1] = (u32x4){ow[4], ow[5], ow[6], ow[7]};
    }
#undef HC_LOAD
}

__device__ __forceinline__ bf16x8 tr_frag(LAS unsigned char* p0, int hi_off) {
    const s16x4 lo = __builtin_amdgcn_ds_read_tr16_b64_v4i16((LAS s16x4*)p0);
    const s16x4 hi = __builtin_amdgcn_ds_read_tr16_b64_v4i16((LAS s16x4*)(p0 + hi_off));
    return (bf16x8){lo[0], lo[1], lo[2], lo[3], hi[0], hi[1], hi[2], hi[3]};
}
constexpr int R_RS = 288;
constexpr int RP_KS = 0, RP_V1 = 128 * R_RS, RP_V2 = 2 * 128 * R_RS, RP_ROT = 3 * 128 * R_RS;
static_assert(RP_ROT + 16384 <= LDS_BARW, "parallel retention LDS map");
constexpr int NRC = (CL + T) / 128;
__device__ __forceinline__ int retp_row(int b, int sp) { return sp < CL ? M_LAT + b * CL + sp : b * T + (sp - CL); }
__device__ __forceinline__ void retp_stage_k(const bf16_t* P, int b, int h, int j, LAS unsigned char* lds) {
    const int tid = threadIdx.x;
#pragma unroll
    for (int i = 0; i < 2; ++i) { const int task = tid + 512 * i, p = task >> 3, sec = (task >> 2) & 1, fg = task & 3;
        const int sp = j * 128 + p;
        const bf16_t* pr = P + (size_t)retp_row(b, sp) * LDP0 + 4096 + h * 128 + sec * 64 + 8 * fg;
        const u32x4 r1 = *(const u32x4*)pr, r2 = *(const u32x4*)(pr + 32);
        f32x4 c0 = (f32x4){1.f, 1.f, 1.f, 1.f}, c1 = c0, s0 = (f32x4){0.f, 0.f, 0.f, 0.f}, s1 = s0;
        if (sp >= CL) { const int t = sp - CL; const int pos = sec ? (t & 63) : (t >> 6);
            const LAS f32x4* cp = (const LAS f32x4*)(lds + RP_ROT + (pos * 32 + 8 * fg) * 4); const LAS f32x4* spp = (const LAS f32x4*)(lds + RP_ROT + 8192 + (pos * 32 + 8 * fg) * 4);
            c0 = cp[0]; c1 = cp[1]; s0 = spp[0]; s1 = spp[1]; }
        const float cc[8] = {c0[0], c0[1], c0[2], c0[3], c1[0], c1[1], c1[2], c1[3]}, ss[8] = {s0[0], s0[1], s0[2], s0[3], s1[0], s1[1], s1[2], s1[3]};
        const unsigned k1w[4] = {r1.x, r1.y, r1.z, r1.w}, k2w[4] = {r2.x, r2.y, r2.z, r2.w};
        unsigned o1[4], o2[4];
#pragma unroll
        for (int w = 0; w < 4; ++w) { const float ka0 = bflo(k1w[w]), ka1 = bfhi(k1w[w]), kb0 = bflo(k2w[w]), kb1 = bfhi(k2w[w]);
            const float ce = cc[2 * w], co = cc[2 * w + 1], se = ss[2 * w], so = ss[2 * w + 1];
            o1[w] = pk2(ka0 * ce - kb0 * se, ka1 * co - kb1 * so); o2[w] = pk2(ka0 * se + kb0 * ce, ka1 * so + kb1 * co); }
        const int off = p * R_RS + (sec * 64 + 8 * fg) * 2;
        *(LAS u32x4*)(lds + RP_KS + off) = (u32x4){o1[0], o1[1], o1[2], o1[3]}; *(LAS u32x4*)(lds + RP_KS + off + 64) = (u32x4){o2[0], o2[1], o2[2], o2[3]}; }
}
__device__ __forceinline__ void retp_kv_unit(int unit, const bf16_t* P, const float* rotg, const float* gamma_logit, bf16_t* KVT, LAS unsigned char* lds) {
    const int tid = threadIdx.x, lane = tid & 63, wv = __builtin_amdgcn_readfirstlane(tid >> 6);
    const int j = unit % NRC, h = (unit / NRC) & 7, b = unit / (NRC * 8);
    const int l15 = lane & 15, q = lane >> 4, trq = l15 >> 2, trp = lane & 3;
    const float lgf = -log1pf(expf(-gamma_logit[h])) * 1.4426950408889634f, lgb = -log1pf(expf(-gamma_logit[8 + h])) * 1.4426950408889634f;
    __syncthreads();
    retp_stage_k(P, b, h, j, lds);
#pragma unroll
    for (int i = 0; i < 4; ++i) { const int piece = tid + 512 * i, p = piece >> 4, ch = piece & 15;
        const u32x4 v = *(const u32x4*)(P + (size_t)retp_row(b, j * 128 + p) * LDP0 + 5120 + h * 128 + 8 * ch); const unsigned vw[4] = {v.x, v.y, v.z, v.w};
        const float sf = exp2f(lgf * (float)(127 - p)), sb = exp2f(lgb * (float)p);
        unsigned of[4], ob[4];
#pragma unroll
        for (int w = 0; w < 4; ++w) { of[w] = pk2(bflo(vw[w]) * sf, bfhi(vw[w]) * sf); ob[w] = pk2(bflo(vw[w]) * sb, bfhi(vw[w]) * sb); }
        *(LAS u32x4*)(lds + RP_V1 + p * R_RS + ch * 16) = (u32x4){of[0], of[1], of[2], of[3]}; *(LAS u32x4*)(lds + RP_V2 + p * R_RS + ch * 16) = (u32x4){ob[0], ob[1], ob[2], ob[3]}; }
    __syncthreads();
    f32x4 acc[2][8];
#pragma unroll
    for (int d = 0; d < 2; ++d)
#pragma unroll
        for (int c = 0; c < 8; ++c) acc[d][c] = (f32x4){0.f, 0.f, 0.f, 0.f};
#pragma unroll
    for (int kk = 0; kk < 4; ++kk) { const bf16x8 ktf = tr_frag(lds + RP_KS + (32 * kk + 8 * q + trq) * R_RS + (16 * wv + 4 * trp) * 2, 4 * R_RS);
#pragma unroll
        for (int c = 0; c < 8; ++c) { const bf16x8 v1 = tr_frag(lds + RP_V1 + (32 * kk + 8 * q + trq) * R_RS + (16 * c + 4 * trp) * 2, 4 * R_RS), v2 = tr_frag(lds + RP_V2 + (32 * kk + 8 * q + trq) * R_RS + (16 * c + 4 * trp) * 2, 4 * R_RS);
            acc[0][c] = __builtin_amdgcn_mfma_f32_16x16x32_bf16(ktf, v1, acc[0][c], 0, 0, 0); acc[1][c] = __builtin_amdgcn_mfma_f32_16x16x32_bf16(ktf, v2, acc[1][c], 0, 0, 0); } }
    const int nb = j < 2 ? 1 - j : 35 - j;
#pragma unroll
    for (int d = 0; d < 2; ++d) { bf16_t* dst = KVT + ((size_t)(((b * 8 + h) * 2 + d) * NRC + (d ? nb : j))) * 16384 + (size_t)l15 * 128 + 16 * wv + 4 * q;
#pragma unroll
        for (int c = 0; c < 8; ++c) { u32x2 w; w.x = pk2(acc[d][c][0], acc[d][c][1]); w.y = pk2(acc[d][c][2], acc[d][c][3]); *(u32x2*)(dst + (size_t)(16 * c) * 128) = w; } }
}
__device__ __forceinline__ void retp_scan_unit(int unit, const float* gamma_logit, const bf16_t* KVT, bf16_t* ST) {
    const int tid = threadIdx.x;
    const int bhd = unit >> 2, qtr = unit & 3, d = bhd & 1, h = (bhd >> 1) & 7;
    const float g128 = exp2f(-log1pf(expf(-gamma_logit[d * 8 + h])) * 1.4426950408889634f * 128.f);
    const u32x4* src = (const u32x4*)(KVT + (size_t)bhd * NRC * 16384) + qtr * 512 + tid; u32x4* dst = (u32x4*)(ST + (size_t)bhd * NRC * 16384) + qtr * 512 + tid;
    u32x4 kv[NRC];
#pragma unroll
    for (int n = 0; n < NRC; ++n) kv[n] = src[(size_t)n * 2048];
    float st[8];
#pragma unroll
    for (int k = 0; k < 8; ++k) st[k] = 0.f;
#pragma unroll
    for (int n = 0; n < NRC; ++n) {
        dst[(size_t)n * 2048] = (u32x4){pk2(st[0], st[1]), pk2(st[2], st[3]), pk2(st[4], st[5]), pk2(st[6], st[7])};
        const unsigned w[4] = {kv[n].x, kv[n].y, kv[n].z, kv[n].w};
#pragma unroll
        for (int k = 0; k < 4; ++k) { st[2 * k] = g128 * st[2 * k] + bflo(w[k]); st[2 * k + 1] = g128 * st[2 * k + 1] + bfhi(w[k]); }
    }
}
__device__ __forceinline__ void retp_out_unit(int unit, const bf16_t* P, const float* rotg, const float* gamma_logit, const bf16_t* ST, const float* gain, bf16_t* AO, LAS unsigned char* lds) {
    const int tid = threadIdx.x, lane = tid & 63, wv = __builtin_amdgcn_readfirstlane(tid >> 6);
    const int j = unit % NRC, h = (unit / NRC) & 7, b = unit / (NRC * 8);
    const int l15 = lane & 15, q = lane >> 4, trq = l15 >> 2, trp = lane & 3;
    const float lgf = -log1pf(expf(-gamma_logit[h])) * 1.4426950408889634f, lgb = -log1pf(expf(-gamma_logit[8 + h])) * 1.4426950408889634f;
    const float qscale = 0.08838834764831845f;
    __syncthreads();
    const int nbk = j < 2 ? 1 - j : 35 - j;
    const bf16_t* sF = ST + ((size_t)(((b * 8 + h) * 2 + 0) * NRC + j)) * 16384; const bf16_t* sB = ST + ((size_t)(((b * 8 + h) * 2 + 1) * NRC + nbk)) * 16384;
    u32x4 vr[4], sfr[4], sbr[4], gtr[4];
#pragma unroll
    for (int i = 0; i < 4; ++i) { const int piece = tid + 512 * i, p = piece >> 4, ch = piece & 15; const bf16_t* prow = P + (size_t)retp_row(b, j * 128 + p) * LDP0 + h * 128 + 8 * ch;
        vr[i] = *(const u32x4*)(prow + 5120); gtr[i] = *(const u32x4*)(prow + 1024); sfr[i] = *(const u32x4*)(sF + (size_t)piece * 8); sbr[i] = *(const u32x4*)(sB + (size_t)piece * 8); }
    __builtin_amdgcn_sched_barrier(0);
    retp_stage_k(P, b, h, j, lds);
#pragma unroll
    for (int i = 0; i < 4; ++i) { const int piece = tid + 512 * i, p = piece >> 4, ch = piece & 15;
        *(LAS u32x4*)(lds + RP_V1 + p * R_RS + ch * 16) = vr[i]; *(LAS u32x4*)(lds + RP_V2 + p * R_RS + ch * 16) = sfr[i]; }
    const int tl = 16 * wv + l15, sp = j * 128 + tl, row = retp_row(b, sp);
    bf16x8 qf[4];
    { const bf16_t* qp = P + (size_t)row * LDP0 + h * 128 + 8 * q;
        u32x4 raw[4];
#pragma unroll
        for (int kk = 0; kk < 4; ++kk) raw[kk] = *(const u32x4*)(qp + 32 * kk);
#pragma unroll
        for (int sec = 0; sec < 2; ++sec) { f32x4 c0 = (f32x4){1.f, 1.f, 1.f, 1.f}, c1 = c0, s0 = (f32x4){0.f, 0.f, 0.f, 0.f}, s1 = s0;
            if (sp >= CL) { const int t = sp - CL; const int pos = sec ? (t & 63) : (t >> 6);
                const LAS f32x4* cp = (const LAS f32x4*)(lds + RP_ROT + (pos * 32 + 8 * q) * 4); const LAS f32x4* spp = (const LAS f32x4*)(lds + RP_ROT + 8192 + (pos * 32 + 8 * q) * 4);
                c0 = cp[0]; c1 = cp[1]; s0 = spp[0]; s1 = spp[1]; }
            const float cc[8] = {c0[0], c0[1], c0[2], c0[3], c1[0], c1[1], c1[2], c1[3]}, ss[8] = {s0[0], s0[1], s0[2], s0[3], s1[0], s1[1], s1[2], s1[3]};
            const unsigned a1[4] = {raw[2 * sec].x, raw[2 * sec].y, raw[2 * sec].z, raw[2 * sec].w}, a2[4] = {raw[2 * sec + 1].x, raw[2 * sec + 1].y, raw[2 * sec + 1].z, raw[2 * sec + 1].w};
            unsigned o1[4], o2[4];
#pragma unroll
            for (int w = 0; w < 4; ++w) { const float qa0 = bflo(a1[w]) * qscale, qa1 = bfhi(a1[w]) * qscale, qb0 = bflo(a2[w]) * qscale, qb1 = bfhi(a2[w]) * qscale;
                const float ce = cc[2 * w], co = cc[2 * w + 1], se = ss[2 * w], so = ss[2 * w + 1];
                o1[w] = pk2(qa0 * ce - qb0 * se, qa1 * co - qb1 * so); o2[w] = pk2(qa0 * se + qb0 * ce, qa1 * so + qb1 * co); }
            qf[2 * sec] = __builtin_bit_cast(bf16x8, (u32x4){o1[0], o1[1], o1[2], o1[3]}); qf[2 * sec + 1] = __builtin_bit_cast(bf16x8, (u32x4){o2[0], o2[1], o2[2], o2[3]}); } }
    const float fa = exp2f(lgf * (float)l15), ba = exp2f(-lgb * (float)l15);
    float fbq[4], bbq[4];
#pragma unroll
    for (int r = 0; r < 4; ++r) { fbq[r] = exp2f(-lgf * (float)(4 * q + r)); bbq[r] = exp2f(lgb * (float)(4 * q + r)); }
    __syncthreads();
    f32x4 acc[8];
#pragma unroll
    for (int c = 0; c < 8; ++c) acc[c] = (f32x4){0.f, 0.f, 0.f, 0.f};
#pragma unroll
    for (int m = 0; m < 4; ++m) {
        unsigned pk[4];
#pragma unroll
        for (int hf = 0; hf < 2; ++hf) { const int st = 2 * m + hf;
            f32x4 X = (f32x4){0.f, 0.f, 0.f, 0.f};
#pragma unroll
            for (int kk = 0; kk < 4; ++kk) { const bf16x8 kf = *(const LAS bf16x8*)(lds + RP_KS + (16 * st + l15) * R_RS + (32 * kk + 8 * q) * 2); X = __builtin_amdgcn_mfma_f32_16x16x32_bf16(kf, qf[kk], X, 0, 0, 0); }
            float f[4];
            if (st < wv) { const float cf = exp2f(lgf * (float)(16 * (wv - st))) * fa;
#pragma unroll
                for (int r = 0; r < 4; ++r) f[r] = cf * fbq[r]; }
            else if (st > wv) { const float cb = exp2f(lgb * (float)(16 * (st - wv))) * ba;
#pragma unroll
                for (int r = 0; r < 4; ++r) f[r] = cb * bbq[r]; }
            else {
#pragma unroll
                for (int r = 0; r < 4; ++r) { const int sl = 4 * q + r; f[r] = sl < l15 ? fa * fbq[r] : (sl > l15 ? ba * bbq[r] : 2.f); } }
            pk[2 * hf] = pk2(X[0] * f[0], X[1] * f[1]); pk[2 * hf + 1] = pk2(X[2] * f[2], X[3] * f[3]); }
        const bf16x8 pa = __builtin_bit_cast(bf16x8, (u32x4){pk[0], pk[1], pk[2], pk[3]});
#pragma unroll
        for (int c = 0; c < 8; ++c) { const bf16x8 vf = tr_frag(lds + RP_V1 + (32 * m + 4 * q + trq) * R_RS + (16 * c + 4 * trp) * 2, 16 * R_RS);
            acc[c] = __builtin_amdgcn_mfma_f32_16x16x32_bf16(vf, pa, acc[c], 0, 0, 0); }
    }
#pragma unroll
    for (int d = 0; d < 2; ++d) {
        if (d == 1) { lds_barrier();
#pragma unroll
            for (int i = 0; i < 4; ++i) { const int piece = tid + 512 * i, p = piece >> 4, ch = piece & 15;
                *(LAS u32x4*)(lds + RP_KS + p * R_RS + ch * 16) = sbr[i]; *(LAS u32x4*)(lds + RP_V1 + p * R_RS + ch * 16) = gtr[i]; }
            lds_barrier(); }
        const LAS unsigned char* sb = lds + (d ? RP_KS : RP_V2) + l15 * R_RS + (8 * q) * 2;
        f32x4 t2[8];
#pragma unroll
        for (int c = 0; c < 8; ++c) t2[c] = (f32x4){0.f, 0.f, 0.f, 0.f};
#pragma unroll
        for (int kk = 0; kk < 4; ++kk)
#pragma unroll
            for (int c = 0; c < 8; ++c) { const bf16x8 sf = *(const LAS bf16x8*)(sb + (16 * c) * R_RS + 64 * kk); t2[c] = __builtin_amdgcn_mfma_f32_16x16x32_bf16(sf, qf[kk], t2[c], 0, 0, 0); }
        const float sc = d ? exp2f(lgb * (float)(128 - tl)) : exp2f(lgf * (float)(tl + 1));
#pragma unroll
        for (int c = 0; c < 8; ++c) acc[c] += t2[c] * sc;
    }
    float ss = 0.f;
#pragma unroll
    for (int c = 0; c < 8; ++c) ss += (acc[c][0] * acc[c][0] + acc[c][1] * acc[c][1]) + (acc[c][2] * acc[c][2] + acc[c][3] * acc[c][3]);
    ss += __shfl_xor(ss, 16); ss += __shfl_xor(ss, 32);
    const float rstd = rsqrtf(ss * (1.f / 128.f) + EPS);
    const LAS unsigned char* gp = lds + RP_V1 + tl * R_RS + (4 * q) * 2; bf16_t* op = AO + (size_t)row * D + h * 128 + 4 * q; const float* gn = gain + h * 128 + 4 * q;
#pragma unroll
    for (int c = 0; c < 8; ++c) { const u32x2 gw = *(const LAS u32x2*)(gp + 32 * c); const f32x4 g4 = *(const f32x4*)(gn + 16 * c);
        u32x2 o; o.x = pk2(acc[c][0] * rstd * g4[0] * silu_f(bflo(gw.x)), acc[c][1] * rstd * g4[1] * silu_f(bfhi(gw.x)));
        o.y = pk2(acc[c][2] * rstd * g4[2] * silu_f(bflo(gw.y)), acc[c][3] * rstd * g4[3] * silu_f(bfhi(gw.y)));
        *(u32x2*)(op + 16 * c) = o; }
}

constexpr int G_RS = 160, G_RSV = 288;
constexpr int G_QS = 0, G_KS = 64 * G_RS, G_KP = 2 * 64 * G_RS, G_VS = 3 * 64 * G_RS, G_ST = G_VS + 64 * G_RSV, G_SEG = G_ST + 128 * G_RS, G_BEND = G_SEG + 8 * 64 * 4, G_END = G_BEND + 256;
__device__ __forceinline__ int gla_lowrow(int b, int dir, int sp0) { return sp0 < CL ? M_LAT + b * CL + (dir ? CL - 64 - sp0 : sp0) : b * T + (dir ? T - 64 - (sp0 - CL) : sp0 - CL); }
__device__ __forceinline__ int gla_row(int b, int dir, int sp) { return sp < CL ? M_LAT + b * CL + (dir ? CL - 1 - sp : sp) : b * T + (dir ? T - 1 - (sp - CL) : sp - CL); }
__device__ __forceinline__ void gla_fast_unit(int unit, const bf16_t* P, const float* w_up, const float* b_up, float* Of, float* Ob, LAS unsigned char* lds0) {
    const int tid = threadIdx.x, lane = tid & 63, wv = __builtin_amdgcn_readfirstlane(tid >> 6);
    const int dir = unit & 1, h = (unit >> 1) & 7, b = unit >> 4;
    const int l15 = lane & 15, q = lane >> 4, trq = l15 >> 2, trp = lane & 3;
    float* O = dir ? Ob : Of;
    constexpr int NCH = (CL + T) / 64;
    static_assert(2 * G_END <= LDS_BARW, "GLA double buffer");
    __syncthreads();
    if (wv < 4) {
        const int mw = wv;
        const unsigned ooff = (unsigned)((dir ? 63 - l15 : l15) * 2048 + (h * 128 + 32 * mw + 4 * q) * 2);
        f32x4 S[4][2];
#pragma unroll
        for (int dt = 0; dt < 4; ++dt) { S[dt][0] = (f32x4){0.f, 0.f, 0.f, 0.f}; S[dt][1] = (f32x4){0.f, 0.f, 0.f, 0.f}; }
        for (int cidx = -1; cidx < NCH + 1; ++cidx) {
            LAS unsigned char* lds = lds0 + (cidx & 1) * G_END;
            lds_barrier();
            if (cidx >= CL / 64 && cidx < NCH) {
                bf16x8 sfr[2][2];
#pragma unroll
                for (int kk = 0; kk < 2; ++kk)
#pragma unroll
                    for (int et = 0; et < 2; ++et) { const u32x4 w = (u32x4){pk2(S[2 * kk][et][0], S[2 * kk][et][1]), pk2(S[2 * kk][et][2], S[2 * kk][et][3]), pk2(S[2 * kk + 1][et][0], S[2 * kk + 1][et][1]), pk2(S[2 * kk + 1][et][2], S[2 * kk + 1][et][3])};
                        sfr[kk][et] = __builtin_bit_cast(bf16x8, w); }
                bf16x8 kf[4][2];
#pragma unroll
                for (int st = 0; st < 4; ++st)
#pragma unroll
                    for (int kk = 0; kk < 2; ++kk) { const LAS unsigned char* kp = lds + G_KS + (16 * st + l15) * G_RS + (32 * kk + 4 * q) * 2;
                        const u32x2 a0 = *(const LAS u32x2*)kp, a1 = *(const LAS u32x2*)(kp + 32); kf[st][kk] = __builtin_bit_cast(bf16x8, (u32x4){a0.x, a0.y, a1.x, a1.y}); }
                bf16x8 vfo[2][2];
#pragma unroll
                for (int m = 0; m < 2; ++m)
#pragma unroll
                    for (int et = 0; et < 2; ++et) vfo[m][et] = tr_frag(lds + G_VS + (32 * m + 4 * q + trq) * G_RSV + (32 * mw + 16 * et + 4 * trp) * 2, 16 * G_RSV);
#pragma unroll
                for (int sg = 0; sg < 4; ++sg) {
                    bf16x8 qf[2];
#pragma unroll
                    for (int kk = 0; kk < 2; ++kk) { const LAS unsigned char* qp = lds + G_QS + (16 * sg + l15) * G_RS + (32 * kk + 4 * q) * 2;
                        const u32x2 a0 = *(const LAS u32x2*)qp, a1 = *(const LAS u32x2*)(qp + 32); qf[kk] = __builtin_bit_cast(bf16x8, (u32x4){a0.x, a0.y, a1.x, a1.y}); }
                    f32x4 accO[2] = {(f32x4){0.f, 0.f, 0.f, 0.f}, (f32x4){0.f, 0.f, 0.f, 0.f}};
#pragma unroll
                    for (int kk = 0; kk < 2; ++kk)
#pragma unroll
                        for (int et = 0; et < 2; ++et) accO[et] = __builtin_amdgcn_mfma_f32_16x16x32_bf16(sfr[kk][et], qf[kk], accO[et], 0, 0, 0);
#pragma unroll
                    for (int m = 0; m <= (sg >> 1); ++m) {
                        unsigned pk[4];
#pragma unroll
                        for (int hf = 0; hf < 2; ++hf) { const int st = 2 * m + hf;
                            if (st <= sg) { f32x4 X = (f32x4){0.f, 0.f, 0.f, 0.f};
#pragma unroll
                                for (int kk = 0; kk < 2; ++kk) X = __builtin_amdgcn_mfma_f32_16x16x32_bf16(kf[st][kk], qf[kk], X, 0, 0, 0);
                                if (st == sg) {
#pragma unroll
                                    for (int r = 0; r < 4; ++r) if (4 * q + r > l15) X[r] = 0.f; }
                                pk[2 * hf] = pk2(X[0], X[1]); pk[2 * hf + 1] = pk2(X[2], X[3]); }
                            else { pk[2 * hf] = 0u; pk[2 * hf + 1] = 0u; } }
                        const bf16x8 pa = __builtin_bit_cast(bf16x8, (u32x4){pk[0], pk[1], pk[2], pk[3]});
#pragma unroll
                        for (int et = 0; et < 2; ++et) accO[et] = __builtin_amdgcn_mfma_f32_16x16x32_bf16(vfo[m][et], pa, accO[et], 0, 0, 0);
                    }
                    { char* ob = (char*)O + (size_t)gla_lowrow(b, dir, cidx * 64) * 2048 + (ooff + (unsigned)((dir ? -sg : sg) * 16 * 2048));
#pragma unroll
                        for (int et = 0; et < 2; ++et) { u32x2 w; w.x = pk2(accO[et][0], accO[et][1]); w.y = pk2(accO[et][2], accO[et][3]); *(u32x2*)(ob + 32 * et) = w; } }
                }
            }
            lds_barrier();
            if (cidx >= 0 && cidx < NCH) {
#pragma unroll
                for (int dt = 0; dt < 4; ++dt) { const f32x4 dec = *(const LAS f32x4*)(lds + G_BEND + (16 * dt + 4 * q) * 4); S[dt][0] = S[dt][0] * dec; S[dt][1] = S[dt][1] * dec; }
#pragma unroll
                for (int kk = 0; kk < 2; ++kk) { bf16x8 vs[2];
#pragma unroll
                    for (int et = 0; et < 2; ++et) vs[et] = tr_frag(lds + G_VS + (32 * kk + 8 * q + trq) * G_RSV + (32 * mw + 16 * et + 4 * trp) * 2, 4 * G_RSV);
#pragma unroll
                    for (int dt = 0; dt < 4; ++dt) { const bf16x8 ktf = tr_frag(lds + G_KP + (32 * kk + 8 * q + trq) * G_RS + (16 * dt + 4 * trp) * 2, 4 * G_RS);
                        S[dt][0] = __builtin_amdgcn_mfma_f32_16x16x32_bf16(ktf, vs[0], S[dt][0], 0, 0, 0); S[dt][1] = __builtin_amdgcn_mfma_f32_16x16x32_bf16(ktf, vs[1], S[dt][1], 0, 0, 0); } }
            }
        }
    } else {
        const int pw = wv - 4, ptid = tid - 256;
        bf16x8 wfr[4]; float bu[4];
#pragma unroll
        for (int it = 0; it < 4; ++it) { unsigned w[4] = {0u, 0u, 0u, 0u};
            if (q < 2) {
#pragma unroll
                for (int j = 0; j < 4; ++j) w[j] = pk2(w_up[(size_t)(dir * 16 + 8 * q + 2 * j) * 512 + h * 64 + 16 * it + l15], w_up[(size_t)(dir * 16 + 8 * q + 2 * j + 1) * 512 + h * 64 + 16 * it + l15]); }
            wfr[it] = __builtin_bit_cast(bf16x8, (u32x4){w[0], w[1], w[2], w[3]}); bu[it] = b_up[dir * 512 + h * 64 + 16 * it + l15]; }
        u32x4 graw0; unsigned short qr0[4][4], kr0[4][4]; u32x4 vraw0[4];
        const unsigned goff = (unsigned)((dir ? 63 - (16 * pw + l15) : 16 * pw + l15) * (LDP1 * 2) + (6144 + dir * 16 + 8 * q) * 2);
        unsigned qkoff[4], voff[4];
#pragma unroll
        for (int r = 0; r < 4; ++r) { const int p = 16 * pw + 4 * q + r; qkoff[r] = (unsigned)((dir ? 63 - p : p) * (LDP1 * 2) + (h * 64 + l15) * 2); }
#pragma unroll
        for (int i = 0; i < 4; ++i) { const int piece = ptid + 256 * i, p = piece >> 4, ch = piece & 15; voff[i] = (unsigned)((dir ? 63 - p : p) * (LDP1 * 2) + (5120 + h * 128 + 8 * ch) * 2); }
#define GLA_LOAD(cc, graw, qr, kr, vraw) do { const char* cb = (const char*)P + (size_t)gla_lowrow(b, dir, (cc) * 64) * (LDP1 * 2); \
            graw = (u32x4){0u, 0u, 0u, 0u}; if (q < 2) graw = *(const u32x4*)(cb + goff); \
            _Pragma("unroll") for (int r = 0; r < 4; ++r) { \
                _Pragma("unroll") for (int it = 0; it < 4; ++it) { qr[it][r] = *(const unsigned short*)(cb + (qkoff[r] + (1024 + 16 * it) * 2)); kr[it][r] = *(const unsigned short*)(cb + (qkoff[r] + (4608 + 16 * it) * 2)); } } \
            _Pragma("unroll") for (int i = 0; i < 4; ++i) vraw[i] = *(const u32x4*)(cb + voff[i]); } while (0)
#define GLA_PREP(cidx_, graw, qr, kr, vraw, ngraw, nqr, nkr, nvraw) do { \
            const int cx = (cidx_); LAS unsigned char* ldn = lds0 + ((cx + 1) & 1) * G_END; const bool act = cx + 1 < NCH; \
            lds_barrier();                                                 \
            float la[4][4]; \
            if (act) { const bf16x8 ga = __builtin_bit_cast(bf16x8, graw); \
                _Pragma("unroll") for (int it = 0; it < 4; ++it) { f32x4 z = __builtin_amdgcn_mfma_f32_16x16x32_bf16(ga, wfr[it], (f32x4){bu[it], bu[it], bu[it], bu[it]}, 0, 0, 0); \
                    float c = 0.f; \
                    _Pragma("unroll") for (int r = 0; r < 4; ++r) { const float z2 = z[r] * 1.4426950408889634f; const float ls = (fminf(z2, 0.f) - __builtin_amdgcn_logf(1.f + __builtin_amdgcn_exp2f(-fabsf(z2)))) * 0.0625f; c += ls; la[it][r] = c; }     \
                    float inc = c; { const float t1 = __shfl_up(inc, 16); if (q >= 1) inc += t1; const float t2 = __shfl_up(inc, 32); if (q >= 2) inc += t2; } \
                    const float exq = inc - c; \
                    _Pragma("unroll") for (int r = 0; r < 4; ++r) la[it][r] += exq; \
                    if (q == 3) ((LAS float*)(ldn + G_SEG))[pw * 64 + 16 * it + l15] = inc; } } \
            lds_barrier();                                                 \
            if (act) { \
                _Pragma("unroll") for (int it = 0; it < 4; ++it) { float pre = 0.f, tot = 0.f; \
                    _Pragma("unroll") for (int w = 0; w < 4; ++w) { const float s = ((LAS float*)(ldn + G_SEG))[w * 64 + 16 * it + l15]; tot += s; pre += (w < pw) ? s : 0.f; } \
                    const float etot = __builtin_amdgcn_exp2f(tot); if (pw == 0 && q == 0) ((LAS float*)(ldn + G_BEND))[16 * it + l15] = etot; \
                    _Pragma("unroll") for (int r = 0; r < 4; ++r) { const int p = 16 * pw + 4 * q + r; const float bb = pre + la[it][r]; const float qv = bf2f(qr[it][r]) * 0.125f, kv = bf2f(kr[it][r]); \
                        const int off = p * G_RS + (16 * it + l15) * 2; \
                        const float kt = kv * __builtin_amdgcn_exp2f(-bb); \
                        *(LAS bf16_t*)(ldn + G_QS + off) = (bf16_t)f2bf(qv * __builtin_amdgcn_exp2f(bb)); \
                        *(LAS bf16_t*)(ldn + G_KS + off) = (bf16_t)f2bf(kt); \
                        *(LAS bf16_t*)(ldn + G_KP + off) = (bf16_t)f2bf(kt * etot); } } \
                _Pragma("unroll") for (int i = 0; i < 4; ++i) { const int piece = ptid + 256 * i, p = piece >> 4, ch = piece & 15; *(LAS u32x4*)(ldn + G_VS + p * G_RSV + ch * 16) = vraw[i]; } \
                if (cx + 2 < NCH) GLA_LOAD(cx + 2, ngraw, nqr, nkr, nvraw); } } while (0)
        GLA_LOAD(0, graw0, qr0, kr0, vraw0);
        for (int cidx = -1; cidx < NCH + 1; cidx += 2) {
            GLA_PREP(cidx, graw0, qr0, kr0, vraw0, graw0, qr0, kr0, vraw0);
            GLA_PREP(cidx + 1, graw0, qr0, kr0, vraw0, graw0, qr0, kr0, vraw0);
        }
#undef GLA_PREP
#undef GLA_LOAD
    }
    __syncthreads();
}

constexpr int GM_RS = 288;
constexpr int GM_VT = 0, GM_RSTD = 128 * GM_RS, GM_GN = 40960, GM_BS = 45056;
__device__ __forceinline__ float gelu_fast(float x) { const float y = 1.5957691216057308f * (x + 0.044715f * x * x * x); return x * __builtin_amdgcn_rcpf(1.f + __expf(-y)); }
__device__ __forceinline__ void gmlp_fast_unit(int ci, const bf16_t* P, const float* gnorm, const bf16_t* Wb, const float* bs_, bf16_t* AO, LAS unsigned char* lds) {
    const int tid = threadIdx.x, lane = tid & 63, wv = __builtin_amdgcn_readfirstlane(tid >> 6);
    const int row0 = ci < 128 ? (ci >> 5) * T + (ci & 31) * 128 : M_LAT + ((ci - 128) >> 1) * CL + ((ci - 128) & 1) * 128;
    const int l15 = lane & 15, q = lane >> 4, trq = l15 >> 2, trp = lane & 3;
    LAS float* rs = (LAS float*)(lds + GM_RSTD);
    LAS float* gnl = (LAS float*)(lds + GM_GN); LAS float* bsl = (LAS float*)(lds + GM_BS);
    __syncthreads();
    *(LAS f32x2*)(gnl + 2 * tid) = *(const f32x2*)(gnorm + 2 * tid); *(LAS f32x2*)(bsl + 2 * tid) = *(const f32x2*)(bs_ + 2 * tid);
    { const int row = tid >> 2, qq = tid & 3; const u32x4* vp = (const u32x4*)(P + (size_t)(row0 + row) * LDP0 + 3072 + qq * 256); float ss = 0.f;
#pragma unroll 4
        for (int i = 0; i < 32; ++i) { const u32x4 w = vp[i]; const unsigned ww[4] = {w.x, w.y, w.z, w.w};
#pragma unroll
            for (int c = 0; c < 4; ++c) { const float a0 = gelu_fast(bflo(ww[c])), a1 = gelu_fast(bfhi(ww[c])); ss += a0 * a0 + a1 * a1; } }
        ss += __shfl_xor(ss, 1); ss += __shfl_xor(ss, 2);
        if (qq == 0) rs[row] = rsqrtf(ss * (1.f / 1024.f) + EPS); }
    __syncthreads();
    const int p = 16 * wv + l15;
    for (int g = 0; g < 8; ++g) {
#pragma unroll
        for (int i = 0; i < 4; ++i) { const int id = tid + 512 * i, s = id >> 4, ch = id & 15;
            const u32x4 w = *(const u32x4*)(P + (size_t)(row0 + s) * LDP0 + 3072 + g * 128 + 8 * ch); const unsigned ww[4] = {w.x, w.y, w.z, w.w};
            const float rr = rs[s]; const f32x4 g0 = *(const LAS f32x4*)(gnl + g * 128 + 8 * ch), g1 = *(const LAS f32x4*)(gnl + g * 128 + 8 * ch + 4);
            const float gg[8] = {g0[0], g0[1], g0[2], g0[3], g1[0], g1[1], g1[2], g1[3]};
            unsigned ow[4];
#pragma unroll
            for (int c = 0; c < 4; ++c) ow[c] = pk2(gelu_fast(bflo(ww[c])) * rr * gg[2 * c], gelu_fast(bfhi(ww[c])) * rr * gg[2 * c + 1]);
            *(LAS u32x4*)(lds + GM_VT + s * GM_RS + ch * 16) = (u32x4){ow[0], ow[1], ow[2], ow[3]}; }
        bf16x8 wf[4];
        { const bf16_t* wp = Wb + (size_t)g * 16384 + (size_t)p * 128 + 8 * q;
#pragma unroll
            for (int kk = 0; kk < 4; ++kk) wf[kk] = *(const bf16x8*)(wp + 32 * kk); }
        u32x2 uwv[8];
        { const bf16_t* up_ = P + (size_t)(row0 + p) * LDP0 + 2048 + g * 128 + 4 * q;
#pragma unroll
            for (int ct = 0; ct < 8; ++ct) uwv[ct] = *(const u32x2*)(up_ + 16 * ct); }
        lds_barrier();
        f32x4 acc[8];
#pragma unroll
        for (int ct = 0; ct < 8; ++ct) acc[ct] = (f32x4){0.f, 0.f, 0.f, 0.f};
#pragma unroll
        for (int kk = 0; kk < 4; ++kk)
#pragma unroll
            for (int ct = 0; ct < 8; ++ct) { const bf16x8 vf = tr_frag(lds + GM_VT + (32 * kk + 8 * q + trq) * GM_RS + (16 * ct + 4 * trp) * 2, 4 * GM_RS);
                acc[ct] = __builtin_amdgcn_mfma_f32_16x16x32_bf16(vf, wf[kk], acc[ct], 0, 0, 0); }
        lds_barrier();
        const float bias = bsl[g * 128 + p];
        bf16_t* op = AO + (size_t)(row0 + p) * D + 1024 + g * 128 + 4 * q;
#pragma unroll
        for (int ct = 0; ct < 8; ++ct) { const u32x2 uw = uwv[ct];
            u32x2 o; o.x = pk2(gelu_fast(bflo(uw.x)) * (acc[ct][0] + bias), gelu_fast(bfhi(uw.x)) * (acc[ct][1] + bias));
            o.y = pk2(gelu_fast(bflo(uw.y)) * (acc[ct][2] + bias), gelu_fast(bfhi(uw.y)) * (acc[ct][3] + bias));
            *(u32x2*)(op + 16 * ct) = o; }
    }
}

constexpr int NA_RSK = 272, NA_RSV = 288;
constexpr int NA_KB = 0, NA_VB = 128 * NA_RSK, NA_BUF = 128 * NA_RSK + 128 * NA_RSV;
constexpr int NA_O1 = 0, NA_ML = 4 * 8192;
static_assert(2 * NA_BUF <= LDS_BARW && NA_ML + 1024 <= 2 * NA_BUF, "NA LDS map");
__device__ __forceinline__ void na_fast_unit(int unit, const bf16_t* P, const float* rpb, bf16_t* AO, LAS unsigned char* lds) {
    const int tid = threadIdx.x, lane = tid & 63, wv = __builtin_amdgcn_readfirstlane(tid >> 6);
    const int cq = wv & 3, kh = wv >> 2;
    const int r = unit & 63, h = (unit >> 6) & 7, b = unit >> 9;
    const int l15 = lane & 15, q = lane >> 4, trq = l15 >> 2, trp = lane & 3;
    const int rstart = min(max(r - 4, 0), 56);
    const int col = 16 * cq + l15, cstart = min(max(col - 8, 0), 48);
    const int ct0 = min(max(cq - 1, 0), 1);
    const float scale = 0.08838834764831845f;
    bf16x8 qf[4];
    { const bf16_t* qp = P + (size_t)(b * T + r * 64 + col) * LDP1 + h * 128 + 8 * q;
#pragma unroll
        for (int kk = 0; kk < 4; ++kk) qf[kk] = *(const bf16x8*)(qp + 32 * kk); }
    u32x4 rk[4], rv[4];
#define NA_LOAD(s) do { _Pragma("unroll") for (int i_ = 0; i_ < 4; ++i_) { const int id = tid + 512 * i_, key = id >> 4, ch = id & 15; \
        const int row = (s) < 4 ? b * T + (rstart + 2 * (s) + (key >> 6)) * 64 + (key & 63) : M_LAT + b * CL + 128 * ((s) - 4) + key; \
        const bf16_t* pr = P + (size_t)row * LDP1 + 2560 + h * 128 + 8 * ch; rk[i_] = *(const u32x4*)pr; rv[i_] = *(const u32x4*)(pr + 1024); } } while (0)
#define NA_STORE(bufp) do { _Pragma("unroll") for (int i_ = 0; i_ < 4; ++i_) { const int id = tid + 512 * i_, key = id >> 4, ch = id & 15; \
        *(LAS u32x4*)((bufp) + NA_KB + key * NA_RSK + ch * 16) = rk[i_]; *(LAS u32x4*)((bufp) + NA_VB + key * NA_RSV + ch * 16) = rv[i_]; } } while (0)
    float m = -1.0e30f, l = 0.f;
    f32x4 accO[8];
#pragma unroll
    for (int c = 0; c < 8; ++c) accO[c] = (f32x4){0.f, 0.f, 0.f, 0.f};
    __syncthreads();
    NA_LOAD(0); NA_STORE(lds);
    __syncthreads();
    for (int s = 0; s < 6; ++s) {
        LAS unsigned char* buf = lds + (s & 1) * NA_BUF;
        if (s + 1 < 6) NA_LOAD(s + 1);
        const bool win = s < 4;
        f32x4 sc[4];
        const int kr = rstart + 2 * s + kh;
        const float* bp = rpb + (h * 15 + (win ? kr - r + 7 : 0)) * 31 - col + 15;
#pragma unroll
        for (int j = 0; j < 4; ++j) {
            if (win && j == 3) { sc[j] = (f32x4){-1.0e30f, -1.0e30f, -1.0e30f, -1.0e30f}; }
            else { const int lk = 64 * kh + (win ? 16 * (ct0 + j) : 16 * j) + l15;
                f32x4 X = (f32x4){0.f, 0.f, 0.f, 0.f};
#pragma unroll
                for (int kk = 0; kk < 4; ++kk) { const bf16x8 kf = *(const LAS bf16x8*)(buf + NA_KB + lk * NA_RSK + (32 * kk + 8 * q) * 2); X = __builtin_amdgcn_mfma_f32_16x16x32_bf16(kf, qf[kk], X, 0, 0, 0); }
                if (win) {
#pragma unroll
                    for (int rg = 0; rg < 4; ++rg) { const int kc = 16 * (ct0 + j) + 4 * q + rg; const bool ok = kc >= cstart && kc < cstart + 16;
                        float bias = 0.f; if (ok) bias = bp[kc];
                        sc[j][rg] = ok ? X[rg] * scale + bias : -1.0e30f; }
                } else sc[j] = X * scale; } }
        float ms = fmaxf(fmaxf(fmaxf(sc[0][0], sc[0][1]), fmaxf(sc[0][2], sc[0][3])), fmaxf(fmaxf(sc[1][0], sc[1][1]), fmaxf(sc[1][2], sc[1][3])));
        ms = fmaxf(ms, fmaxf(fmaxf(fmaxf(sc[2][0], sc[2][1]), fmaxf(sc[2][2], sc[2][3])), fmaxf(fmaxf(sc[3][0], sc[3][1]), fmaxf(sc[3][2], sc[3][3]))));
        ms = fmaxf(ms, __shfl_xor(ms, 16)); ms = fmaxf(ms, __shfl_xor(ms, 32));
        const float mn = fmaxf(m, ms), alpha = __expf(m - mn);
        m = mn;
        float ps = 0.f;
#pragma unroll
        for (int j = 0; j < 4; ++j)
#pragma unroll
            for (int rg = 0; rg < 4; ++rg) { const float p = __expf(sc[j][rg] - mn); sc[j][rg] = p; ps += p; }
        l = l * alpha + ps;
        float az[4];
#pragma unroll
        for (int rg = 0; rg < 4; ++rg) az[rg] = __shfl(alpha, 4 * q + rg);
#pragma unroll
        for (int c = 0; c < 8; ++c)
#pragma unroll
            for (int rg = 0; rg < 4; ++rg) accO[c][rg] *= az[rg];
#pragma unroll
        for (int pi = 0; pi < 2; ++pi) {
            const u32x4 pw = (u32x4){pk2(sc[2 * pi][0], sc[2 * pi][1]), pk2(sc[2 * pi][2], sc[2 * pi][3]), pk2(sc[2 * pi + 1][0], sc[2 * pi + 1][1]), pk2(sc[2 * pi + 1][2], sc[2 * pi + 1][3])};
            const bf16x8 pa = __builtin_bit_cast(bf16x8, pw);
            const int lk0 = 64 * kh + (win ? 16 * (ct0 + 2 * pi) : 32 * pi) + 4 * q + trq;
            const int hoff = (win && pi == 1) ? 0 : 16 * NA_RSV;
#pragma unroll
            for (int c = 0; c < 8; ++c) { const bf16x8 vf = tr_frag(buf + NA_VB + lk0 * NA_RSV + (16 * c + 4 * trp) * 2, hoff);
                accO[c] = __builtin_amdgcn_mfma_f32_16x16x32_bf16(pa, vf, accO[c], 0, 0, 0); }
        }
        if (s + 1 < 6) NA_STORE(lds + ((s + 1) & 1) * NA_BUF);
        lds_barrier();
    }
#undef NA_LOAD
#undef NA_STORE
    l += __shfl_xor(l, 16); l += __shfl_xor(l, 32);
    LAS float* ml = (LAS float*)(lds + NA_ML) + (cq * 2 + kh) * 32;
    if (q == 0) { ml[l15] = m; ml[16 + l15] = l; }
    if (kh == 1) { LAS float* o1 = (LAS float*)(lds + NA_O1 + cq * 8192);
#pragma unroll
        for (int c = 0; c < 8; ++c)
#pragma unroll
            for (int rg = 0; rg < 4; ++rg) o1[(4 * q + rg) * 128 + 16 * c + l15] = accO[c][rg]; }
    __syncthreads();
    if (kh == 0) {
        const LAS float* ml0 = (const LAS float*)(lds + NA_ML) + (cq * 2) * 32; const LAS float* ml1 = ml0 + 32;
        const LAS float* o1 = (const LAS float*)(lds + NA_O1 + cq * 8192);
        float f0[4], f1[4];
#pragma unroll
        for (int rg = 0; rg < 4; ++rg) { const int t = 4 * q + rg; const float m0 = ml0[t], m1 = ml1[t], mm = fmaxf(m0, m1);
            const float e0 = __expf(m0 - mm), e1 = __expf(m1 - mm); const float inv = 1.f / (ml0[16 + t] * e0 + ml1[16 + t] * e1);
            f0[rg] = e0 * inv; f1[rg] = e1 * inv; }
#pragma unroll
        for (int rg = 0; rg < 4; ++rg) { bf16_t* op = AO + (size_t)(b * T + r * 64 + 16 * cq + 4 * q + rg) * D + h * 128 + l15;
#pragma unroll
            for (int c = 0; c < 8; ++c) op[16 * c] = (bf16_t)f2bf(accO[c][rg] * f0[rg] + o1[(4 * q + rg) * 128 + 16 * c + l15] * f1[rg]); }
    }
    __syncthreads();
}

__global__ void __launch_bounds__(512, 2) mk_fwd(Args a) {
    extern __shared__ __attribute__((aligned(16))) unsigned char lds_raw[];
    LAS unsigned char* lds = (LAS unsigned char*)lds_raw;
    const int tid = threadIdx.x;
    if (tid < 16) ((LAS unsigned*)(lds + LDS_BARW))[tid] = 0u;
    __syncthreads();
    const int lo = a.lo, hi = a.hi;
    XcdBarrier bar; bar.bar = (unsigned*)(a.ws + WS_CTL) + 4096; bar.x = 0; bar.st = (volatile LAS unsigned*)(lds + LDS_BARW);
    if (hi - lo > 1) bar = xcd_barrier_post((unsigned*)(a.ws + WS_CTL) + 4096, (volatile LAS unsigned*)(lds + LDS_BARW));
#ifdef ONLY_PHASE
#define IN(k) ((k) == ONLY_PHASE && lo <= (k) && (k) < hi)
#else
#define IN(k) (lo <= (k) && (k) < hi)
#endif
#define SEAM(k) do { if (IN(k) && IN((k) + 1)) xcd_barrier(bar); } while (0)
#ifndef DUPMASK
#define DUPMASK 0u
#endif
#define REPS(k) for (int rep = 0; rep < 1 + (int)((DUPMASK >> (k)) & 1u); ++rep)
#define REPBAR() do { if (rep) xcd_barrier(bar); } while (0)
    unsigned char* ws = a.ws;
    float* MOD = (float*)(ws + WS_MOD);
    const float* rotc = (const float*)(ws + WS_ROT); const float* rots = rotc + 2048;
    float* AFF = (float*)(ws + WS_AFF); int* SRC = (int*)(ws + WS_SRC); float* GATE = (float*)(ws + WS_GATE); int* INV = (int*)(ws + WS_INV);
    bf16_t* Win0 = (bf16_t*)(ws + WS_WIN0); bf16_t* Wout0 = (bf16_t*)(ws + WS_WOUT0); bf16_t* Win1 = (bf16_t*)(ws + WS_WIN1); bf16_t* Wout1 = (bf16_t*)(ws + WS_WOUT1);
    bf16_t* Wgu = (bf16_t*)(ws + WS_WGU); bf16_t* Wdn = (bf16_t*)(ws + WS_WDN);
    bf16_t* X1 = (bf16_t*)(ws + WS_X1); bf16_t* Hb = (bf16_t*)(ws + WS_HB); bf16_t* Pb = (bf16_t*)(ws + WS_P); bf16_t* AO = (bf16_t*)(ws + WS_AO);
    float* Of = (float*)(ws + WS_OF); float* Ob = (float*)(ws + WS_OB);
    bf16_t* Xg = (bf16_t*)(ws + WS_XG); bf16_t* Hm = (bf16_t*)(ws + WS_HM); bf16_t* Ye = (bf16_t*)(ws + WS_YE);
    const int G = gridDim.x, bid = blockIdx.x;

    if (IN(0)) REPS(0) { REPBAR(); phase_prologue(a, lds); }
    SEAM(0);
    if (IN(1)) REPS(1) { REPBAR(); phase_modnorm(a.in[I_X], a.in[I_CTX], M_ALL, a.in[I_NMIX], MOD, 0, D, Hb); }
    SEAM(1);
    if (IN(2)) REPS(2) { REPBAR();  pg8::Gemm g{Hb, Win0, D}; pg8::StaticOrder S; S.init(M_ALL, LDP0, G, bid, M_LAT); pg8::EpiStore E{Pb, LDP0}; pg8::gemm_phase(lds, g, S, E); }
    SEAM(2);
    if (IN(3)) {
        for (int i = tid; i < 4096; i += 512) ((LAS float*)(lds + RP_ROT))[i] = rotc[i];
        unsigned* qctr3 = (unsigned*)(ws + WS_CTL) + 8192 + 256;
        for (;;) {
            __syncthreads();
            if (tid == 0) *(volatile LAS unsigned*)(lds + LDS_BARW + 32) = atomicAdd(qctr3, 1u);
            __syncthreads();
            const unsigned u = *(volatile LAS unsigned*)(lds + LDS_BARW + 32);
            if (u >= 136u + (unsigned)(NB * 8 * NRC)) break;
            if (u < 136u) gmlp_fast_unit((int)u, Pb, a.in[I_GMLPN], (const bf16_t*)(ws + WS_GMW), a.in[I_GMLPB], AO, lds);
            else retp_kv_unit((int)u - 136, Pb, rotc, a.in[I_GAMMA], (bf16_t*)(ws + WS_OF), lds);
        }
    }
    if (IN(3) && IN(4)) xcd_barrier(bar);
    if (IN(4)) { for (int u = bid; u < NB * 8 * 2 * 4; u += G) retp_scan_unit(u, a.in[I_GAMMA], (const bf16_t*)(ws + WS_OF), (bf16_t*)(ws + WS_OB)); }
    if (IN(4) && IN(8)) xcd_barrier(bar);
    if (IN(8)) {
        for (int i = tid; i < 4096; i += 512) ((LAS float*)(lds + RP_ROT))[i] = rotc[i];
        for (int u = bid; u < NB * 8 * NRC; u += G) retp_out_unit(u, Pb, rotc, a.in[I_GAMMA], (const bf16_t*)(ws + WS_OB), a.in[I_RETN], AO, lds);
    }
    if (IN(8) && IN(5)) xcd_barrier(bar);
    if (IN(5)) REPS(5) { REPBAR();  pg8::Gemm g{AO, Wout0, D}; pg8::StaticOrder S; S.init(M_ALL, D, G, bid, M_LAT); pg8::EpiResid<false> E{a.in[I_X], a.in[I_CTX], X1, MOD + 2 * D}; pg8::gemm_phase(lds, g, S, E); }
    SEAM(5);
    if (IN(6)) REPS(6) { REPBAR(); phase_modnorm_router(X1, M_ALL, a.in[I_NFFN], MOD, 3 * D, 4 * D, Hb, a.in[I_ROUTER], AFF, lds); }
    SEAM(6);
    if (IN(7)) REPS(7) { REPBAR(); phase_topk(AFF, SRC, GATE, INV, RPE0, true, lds); }
    if (IN(7) && IN(9)) xcd_barrier(bar);
    if (IN(9)) REPS(9) { REPBAR();  pg8::Gemm g{Hb, Wgu, D}; pg8::MoeOrder S; S.init(RPE0 / 256, 16, G, bid, 8); pg8::EpiSiluMul E{Hm}; pg8::gemm_phase<pg8::EpiSiluMul, pg8::MoeOrder, true>(lds, g, S, E, SRC); }
    SEAM(9);
    if (IN(10)) REPS(10) { REPBAR();  pg8::Gemm g{Hm, nullptr, D}; pg8::BSrcF32 bs{a.in[I_WDOWN], a.in[I_WDOWN], 8, 256, 128}; pg8::MoeOrder S; S.init(RPE0 / 256, 8, G, bid, 8); pg8::EpiStore E{Ye, D}; pg8::gemm_phase_fb<pg8::EpiStore, pg8::MoeOrder, false, true>(lds, g, bs, S, E); }
    SEAM(10);
    if (IN(11)) REPS(11) { REPBAR(); phase_moe_combine<false>(X1, Ye, INV, GATE, MOD + 5 * D, M_ALL, a.in[I_NMIX] + D, MOD + 5 * 12288, Hb, nullptr); }
    SEAM(11);
    if (IN(12)) REPS(12) { REPBAR();  pg8::Gemm g{Hb, Win1, D}; pg8::StaticOrderTailCols<10> S; S.init(M_ALL, LDP1, G, bid, M_LAT); pg8::EpiStore E{Pb, LDP1}; pg8::gemm_phase(lds, g, S, E); }
    SEAM(12);
    if (IN(13)) REPS(13) {
        REPBAR();
        if (bid < 64) { gla_fast_unit(bid, Pb, a.in[I_GLAWUP], a.in[I_GLABUP], Of, Ob, lds); }
        unsigned* qctr = (unsigned*)(ws + WS_CTL) + 8192 + 64 * rep;
        for (;;) {
            __syncthreads();
            if (tid == 0) *(volatile LAS unsigned*)(lds + LDS_BARW + 32) = atomicAdd(qctr, 1u);
            __syncthreads();
            const unsigned u = *(volatile LAS unsigned*)(lds + LDS_BARW + 32);
            if (u >= (unsigned)(NB * 8 * 64)) break;
            na_fast_unit((int)u, Pb, a.in[I_RPB], AO, lds);
        }
    }
    SEAM(13);
    if (IN(14)) REPS(14) { REPBAR(); phase_head_combine_bf16((const bf16_t*)Of, (const bf16_t*)Ob, Pb, LDP1, 1536, a.in[I_GLAN], AO, 1024, M_LAT); }
    SEAM(14);
    if (IN(15)) REPS(15) { REPBAR();  pg8::Gemm g{AO, Wout1, D}; pg8::StaticOrder S; S.init(M_LAT, D, G, bid); pg8::EpiResid<true> E{nullptr, nullptr, X1, MOD + 5 * 12288 + 2 * D}; pg8::gemm_phase(lds, g, S, E); }
    SEAM(15);
    if (IN(16)) REPS(16) { REPBAR(); phase_modnorm_router(X1, M_LAT, a.in[I_NFFN] + D, MOD + 5 * 12288, 3 * D, 4 * D, Hb, a.in[I_ROUTER] + (size_t)D * NE, AFF, lds); }
    SEAM(16);
    if (IN(17)) REPS(17) { REPBAR(); phase_topk(AFF, SRC, GATE, INV, RPE1, false, lds); }
    if (IN(17) && IN(19)) xcd_barrier(bar);
    if (IN(19)) REPS(19) { REPBAR();  pg8::Gemm g{Hb, Wgu + (size_t)NE * 4096 * 2048, D}; pg8::MoeOrder S; S.init(RPE1 / 256, 16, G, bid); pg8::EpiSiluMul E{Hm}; pg8::gemm_phase<pg8::EpiSiluMul, pg8::MoeOrder, true>(lds, g, S, E, SRC); }
    SEAM(19);
    if (IN(20)) REPS(20) { REPBAR();  pg8::Gemm g{Hm, nullptr, D}; pg8::BSrcF32 bs{a.in[I_WDOWN] + (size_t)NE * 2048 * 2048, a.in[I_WDOWN] + (size_t)NE * 2048 * 2048, 8, 256, 128}; pg8::MoeOrder S; S.init(RPE1 / 256, 8, G, bid); pg8::EpiStore E{Ye, D}; pg8::gemm_phase_fb<pg8::EpiStore, pg8::MoeOrder, false>(lds, g, bs, S, E); }
    SEAM(20);
    if (IN(21)) REPS(21) { REPBAR(); phase_moe_combine<true>(X1, Ye, INV, GATE, MOD + 5 * 12288 + 5 * D, M_LAT, a.in[I_NFIN], nullptr, nullptr, a.out); }
#undef IN
#undef SEAM
}

extern "C" void kernel_launch(void* const* d_in, const int* in_sizes, int n_in, void* d_out, int out_size, void* d_ws, size_t ws_size, hipStream_t stream) {
    static int grid = 0;
    if (grid == 0) {
        if (n_in != 26 || out_size != M_LAT * D || ws_size < WS_END) { fprintf(stderr, "kernel_launch: unexpected problem (n_in %d, out %d, ws %zu < %zu)\n", n_in, out_size, ws_size, (size_t)WS_END); grid = -1; return; }
        int dev = 0, cus = 0, per_cu = 0;
        if (hipGetDevice(&dev) != hipSuccess || hipDeviceGetAttribute(&cus, hipDeviceAttributeMultiprocessorCount, dev) != hipSuccess) { grid = -1; return; }
        if (hipFuncSetAttribute((const void*)mk_fwd, hipFuncAttributeMaxDynamicSharedMemorySize, LDS_BYTES) != hipSuccess) { fprintf(stderr, "kernel_launch: hipFuncSetAttribute failed\n"); grid = -1; return; }
        if (hipOccupancyMaxActiveBlocksPerMultiprocessor(&per_cu, (const void*)mk_fwd, 512, LDS_BYTES) != hipSuccess || per_cu < 1) fprintf(stderr, "kernel_launch: occupancy query says %d\n", per_cu);
        (void)hipGetLastError();
        grid = cus;
    }
    if (grid < 0) return;
    (void)hipMemsetAsync((char*)d_ws + WS_CTL, 0, 65536, stream);
    Args a{};
    for (int i = 0; i < 26; ++i) a.in[i] = (const float*)d_in[i];
    a.out = (float*)d_out; a.ws = (unsigned char*)d_ws;
#if MK_SPLIT
    { const int order[20] = {0, 1, 2, 3, 4, 8, 5, 6, 7, 9, 10, 11, 12, 13, 14, 15, 16, 17, 19, 20};
        for (int i = 0; i < 20; ++i) { a.lo = order[i]; a.hi = order[i] + 1; hipLaunchKernelGGL(mk_fwd, dim3(grid), dim3(512), LDS_BYTES, stream, a); }
        a.lo = 21; a.hi = 22; hipLaunchKernelGGL(mk_fwd, dim3(grid), dim3(512), LDS_BYTES, stream, a); }
#else
    a.lo = 0; a.hi = NPH; hipLaunchKernelGGL(mk_fwd, dim3(grid), dim3(512), LDS_BYTES, stream, a);
#endif
}
```
